# Optimizing an MI355X kernel written in HIP

```python
import jax, jax.numpy as jnp
from jax import lax
import numpy as np

D_MODEL = 1024
BATCH = 2
SEQ = 8192
DEPTH = 1

PLE_DIM = 256
CONV_HEADS = 8
CONV_HEAD_DIM = 64
CONV_WIDTH = CONV_HEADS * CONV_HEAD_DIM
CONV_K = 3
MLA_HEADS = 8
Q_LORA = 256
KV_LORA = 128
QK_NOPE = 64
QK_ROPE = 32
V_HEAD = 64
MLA_WIDTH = MLA_HEADS * V_HEAD
D_MIX = CONV_WIDTH + MLA_WIDTH
D_IN = 3 * CONV_WIDTH + Q_LORA + KV_LORA + QK_ROPE
D_FF = 2816
FFN_CONV_K = 3
Q_BLOCK = 128
ROPE_THETA = 10000.0
EPS = 1e-6

kernel_name = "hybrid_shortconv_mla_convffn_ple"


def rmsnorm(x, g):
    xf = x.astype(jnp.float32)
    y = xf * lax.rsqrt(jnp.mean(xf * xf, axis=-1, keepdims=True) + EPS)
    return (y * g.astype(jnp.float32)).astype(x.dtype)


def dwconv_centred(x, w, b=None):
    s = x.shape[1]
    xp = jnp.pad(x, ((0, 0), (1, 1), (0, 0)))
    y = xp[:, 0:s] * w[0] + xp[:, 1:s + 1] * w[1] + xp[:, 2:s + 2] * w[2]
    if b is not None:
        y = y + b
    return y


def rope_tables(s, dim, dtype):
    pos = jnp.arange(s, dtype=jnp.float32)
    inv_freq = ROPE_THETA ** (-jnp.arange(0, dim, 2, dtype=jnp.float32) / dim)
    ang = pos[:, None] * inv_freq[None, :]
    ang = jnp.concatenate([ang, ang], axis=-1)
    return jnp.cos(ang).astype(dtype), jnp.sin(ang).astype(dtype)


def rotate_half(x):
    x1, x2 = jnp.split(x, 2, axis=-1)
    return jnp.concatenate([-x2, x1], axis=-1)


def mla_attention(q_nope, q_rope, k_nope, k_rope, v):
    b, s, h, _ = q_nope.shape
    nb = s // Q_BLOCK
    scale = (QK_NOPE + QK_ROPE) ** -0.5
    qn = q_nope.reshape(b, nb, Q_BLOCK, h, QK_NOPE).transpose(1, 0, 2, 3, 4)
    qr = q_rope.reshape(b, nb, Q_BLOCK, h, QK_ROPE).transpose(1, 0, 2, 3, 4)

    def block(args):
        qn_b, qr_b = args
        sc = (jnp.einsum('bqhd,bkhd->bhqk', qn_b, k_nope)
              + jnp.einsum('bqhr,bkr->bhqk', qr_b, k_rope))
        probs = jax.nn.softmax(sc.astype(jnp.float32) * scale, axis=-1).astype(v.dtype)
        return jnp.einsum('bhqk,bkhd->bqhd', probs, v)

    out = lax.map(block, (qn, qr))
    return out.transpose(1, 0, 2, 3, 4).reshape(b, s, h * V_HEAD)


def setup_inputs(seed: int = 0) -> dict:
    key = jax.random.key(seed)
    ks = jax.random.split(key, 20)
    f32 = jnp.float32

    def nrm(k, shape, fan_in):
        return jax.random.normal(k, shape, f32) * (fan_in ** -0.5)

    def gain(k, dim):
        return 1.0 + 0.01 * jax.random.normal(k, (DEPTH, dim), f32)

    return {
        "x": jax.random.normal(ks[0], (BATCH, SEQ, D_MODEL), f32),
        "p": jax.random.normal(ks[1], (DEPTH, BATCH, SEQ, PLE_DIM), f32),
        "norm_mix_g": gain(ks[2], D_MODEL),
        "w_in": nrm(ks[3], (DEPTH, D_MODEL, D_IN), D_MODEL),
        "conv_w": nrm(ks[4], (DEPTH, CONV_K, CONV_WIDTH), CONV_K),
        "q_norm_g": gain(ks[5], Q_LORA),
        "w_uq": nrm(ks[6], (DEPTH, Q_LORA, MLA_HEADS * (QK_NOPE + QK_ROPE)), Q_LORA),
        "kv_norm_g": gain(ks[7], KV_LORA),
        "w_ukv": nrm(ks[8], (DEPTH, KV_LORA, MLA_HEADS * (QK_NOPE + V_HEAD)), KV_LORA),
        "w_o": nrm(ks[9], (DEPTH, D_MIX, D_MODEL), D_MIX),
        "norm_ffn_g": gain(ks[10], D_MODEL),
        "w_up": nrm(ks[11], (DEPTH, D_MODEL, 2 * D_FF), D_MODEL),
        "ffn_conv_w": nrm(ks[12], (DEPTH, FFN_CONV_K, 2 * D_FF), FFN_CONV_K),
        "ffn_conv_b": 0.01 * jax.random.normal(ks[13], (DEPTH, 2 * D_FF), f32),
        "w_down": nrm(ks[14], (DEPTH, D_FF, D_MODEL), D_FF),
        "ple_norm_g": gain(ks[15], D_MODEL),
        "w_ple_gate": nrm(ks[16], (DEPTH, D_MODEL, D_MODEL), D_MODEL),
        "w_ple_proj": nrm(ks[17], (DEPTH, PLE_DIM, D_MODEL), PLE_DIM),
        "final_norm_g": 1.0 + 0.01 * jax.random.normal(ks[18], (D_MODEL,), f32),
    }


def reference(x, p, norm_mix_g, w_in, conv_w, q_norm_g, w_uq, kv_norm_g, w_ukv, w_o,
              norm_ffn_g, w_up, ffn_conv_w, ffn_conv_b, w_down, ple_norm_g,
              w_ple_gate, w_ple_proj, final_norm_g):
    b, s, _ = x.shape
    cos, sin = rope_tables(s, QK_ROPE, x.dtype)
    split_pts = np.cumsum([CONV_WIDTH, CONV_WIDTH, CONV_WIDTH, Q_LORA, KV_LORA])

    for i in range(DEPTH):
        h = rmsnorm(x, norm_mix_g[i])
        z = h @ w_in[i]
        xc, bg, cg, q_lat, kv_lat, k_r = jnp.split(z, split_pts, axis=-1)

        y_conv = bg * dwconv_centred(cg * xc, conv_w[i])

        q = (rmsnorm(q_lat, q_norm_g[i]) @ w_uq[i]).reshape(b, s, MLA_HEADS, QK_NOPE + QK_ROPE)
        q_nope, q_rope = q[..., :QK_NOPE], q[..., QK_NOPE:]
        q_rope = q_rope * cos[None, :, None, :] + rotate_half(q_rope) * sin[None, :, None, :]
        kv = (rmsnorm(kv_lat, kv_norm_g[i]) @ w_ukv[i]).reshape(b, s, MLA_HEADS, QK_NOPE + V_HEAD)
        k_nope, v = kv[..., :QK_NOPE], kv[..., QK_NOPE:]
        k_rope = k_r * cos[None] + rotate_half(k_r) * sin[None]
        y_mla = mla_attention(q_nope, q_rope, k_nope, k_rope, v)

        x = x + jnp.concatenate([y_conv, y_mla], axis=-1) @ w_o[i]

        hf = rmsnorm(x, norm_ffn_g[i])
        a = dwconv_centred(hf @ w_up[i], ffn_conv_w[i], ffn_conv_b[i])
        g, u = jnp.split(a, 2, axis=-1)
        x = x + (jax.nn.silu(g) * u) @ w_down[i]

        gate = jax.nn.sigmoid(rmsnorm(x, ple_norm_g[i]) @ w_ple_gate[i])
        x = x + gate * (p[i] @ w_ple_proj[i])

    return rmsnorm(x, final_norm_g)
```

```cpp
#include <hip/hip_runtime.h>
#include <hip/hip_bf16.h>
#include <cstdio>
#include <cstdint>
#include <cmath>

constexpr int BATCH = 2, SEQ = 8192, DM = 1024, M = BATCH * SEQ;
constexpr int PLE = 256, CONVW = 512, NH = 8, QLORA = 256, KVLORA = 128, NOPE = 64, ROPE = 32, VH = 64, QKD = 96;
constexpr int DIN = 1952, DINP = 2048, DFF = 2816, NUP = 2 * DFF;
constexpr int LDQ = NH * QKD, LDKK = NH * QKD, LDV = NH * VH;
constexpr float EPS = 1e-6f;
constexpr float QSCALE = 0.10206207261596575f * 1.4426950408889634f;
namespace pg8 {
#define PG8_LAS __attribute__((address_space(3)))
typedef unsigned short bf16_t;
typedef short bf16x8 __attribute__((ext_vector_type(8)));
typedef float f32x4 __attribute__((ext_vector_type(4)));
typedef unsigned u32x4 __attribute__((ext_vector_type(4)));
constexpr int BM = 256, BK = 64, HALF = 128, HTB = HALF * BK * 2  , STAGE_BYTES = 8 * HTB, NXCD = 8, WGM = 8;

__host__ __device__ __forceinline__ int lds_byte(int r, int c) { const int st = (r >> 4) * 2 + (c >> 5), rr = r & 15, cc = c & 31, ob = rr * 64 + cc * 2; return st * 1024 + (ob ^ (((ob >> 9) & 1) << 5)); }
__host__ __device__ __forceinline__ void stage_rc(int b, int& R, int& C) { const int st = b / 1024, sb = b % 1024, swz = sb ^ (((sb >> 9) & 1) << 5); R = (st >> 1) * 16 + swz / 64; C = (st & 1) * 32 + (swz % 64) / 2; }
__host__ __device__ __forceinline__ int perm32(int rho) { const int n = rho >> 4, i = rho & 15; return 8 * (i >> 2) + 4 * n + (i & 3); }

struct Unit { int pm, pn, arow, ord; };
struct Gemm { const bf16_t* A; const bf16_t* Bt; int M, N, K; };

struct StaticOrder {
    int nM, nN, nwg, G, c;
    __host__ __device__ void init(int M, int N, int G_, int c_) { nM = M / BM; nN = N / BM; nwg = nM * nN; G = G_; c = c_; }
    __host__ __device__ bool next(int i, Unit& u) const {
        const long L = (long)i * G + c; if (L >= nwg) return false;
        int wgid = (int)L; { const int q = nwg / NXCD, r = nwg % NXCD, xcd = wgid % NXCD, off = wgid / NXCD; wgid = (xcd < r ? xcd * (q + 1) : r * (q + 1) + (xcd - r) * q) + off; }
        const int nig = WGM * nN, gid = wgid / nig, fm = gid * WGM, gsz = (nM - fm) < WGM ? (nM - fm) : WGM;
        u.pm = fm + ((wgid % nig) % gsz); u.pn = (wgid % nig) / gsz; u.arow = u.pm * BM; u.ord = i; return true;
    }
    __device__ __forceinline__ void a_ready(const Unit&) const {}
    __device__ __forceinline__ void done(const Unit&) const {}
};

__device__ __forceinline__ unsigned cvt_pk_bf16(float lo, float hi) { unsigned r; asm volatile("v_cvt_pk_bf16_f32 %0, %1, %2" : "=v"(r) : "v"(lo), "v"(hi)); return r; }
typedef float f32x2 __attribute__((ext_vector_type(2)));
typedef unsigned u32x2 __attribute__((ext_vector_type(2)));
__device__ __forceinline__ u32x2 pack4(const f32x4 v) { u32x2 w; w.x = cvt_pk_bf16(v[0], v[1]); w.y = cvt_pk_bf16(v[2], v[3]); return w; }
__device__ __forceinline__ u32x4 pack8(const f32x4 a, const f32x4 b) { u32x4 w; w.x = cvt_pk_bf16(a[0], a[1]); w.y = cvt_pk_bf16(a[2], a[3]); w.z = cvt_pk_bf16(b[0], b[1]); w.w = cvt_pk_bf16(b[2], b[3]); return w; }
__device__ __forceinline__ f32x4 unpack4(const u32x2 w) { f32x4 v; v[0] = __uint_as_float(w.x << 16); v[1] = __uint_as_float(w.x & 0xffff0000u); v[2] = __uint_as_float(w.y << 16); v[3] = __uint_as_float(w.y & 0xffff0000u); return v; }
__device__ __forceinline__ float rstd16(const float* ssqp, int row) {
    const f32x4* p = (const f32x4*)(ssqp + (size_t)row * 16); const f32x4 a = p[0], b = p[1], c = p[2], d = p[3];
    const float s = ((a[0] + a[1]) + (a[2] + a[3])) + ((b[0] + b[1]) + (b[2] + b[3])) + ((c[0] + c[1]) + (c[2] + c[3])) + ((d[0] + d[1]) + (d[2] + d[3]));
    return rsqrtf(s * (1.0f / 1024.0f) + 1e-6f);
}


struct EpiStoreBf16 {
    static constexpr bool PERM = true, AFTER_DRAIN = false;
    bf16_t* O; int ldc;
    __device__ __forceinline__ void operator()(f32x4 (&acc)[2][2][4][2], const Unit& u, int wr, int wc, int fr, int fq, int lane) const {
        const int row0 = u.pm * BM + wr * 64 + fr, col0 = u.pn * BM + wc * 32 + 8 * fq;
#pragma unroll
        for (int ai = 0; ai < 2; ++ai)
#pragma unroll
            for (int m = 0; m < 4; ++m) { bf16_t* rowp = O + (size_t)(row0 + ai * HALF + m * 16) * ldc + col0;
#pragma unroll
                for (int bj = 0; bj < 2; ++bj) *(u32x4*)(rowp + bj * HALF) = pack8(acc[ai][bj][m][0], acc[ai][bj][m][1]); }
    }
};

struct EpiQ {
    static constexpr bool PERM = false, AFTER_DRAIN = false;
    bf16_t* Q; const float* cosT; const float* sinT; float scale;
    __device__ __forceinline__ void operator()(f32x4 (&acc)[2][2][4][2], const Unit& u, int wr, int wc, int fr, int fq, int lane) const {
        const int row0 = u.pm * BM + wr * 64 + fr;
#pragma unroll
        for (int bj = 0; bj < 2; ++bj) {
            const int gc0 = u.pn * BM + bj * HALF + wc * 32;
            const bool rope = (gc0 % 96) == 64;
#pragma unroll
            for (int ai = 0; ai < 2; ++ai)
#pragma unroll
                for (int m = 0; m < 4; ++m) {
                    const int row = row0 + ai * HALF + m * 16, pos = row & (SEQ - 1);
                    f32x4 v0 = acc[ai][bj][m][0], v1 = acc[ai][bj][m][1];
                    if (rope) { const f32x4 c = *(const f32x4*)(cosT + pos * 16 + 4 * fq), s = *(const f32x4*)(sinT + pos * 16 + 4 * fq);
                        const f32x4 o0 = v0 * c - v1 * s, o1 = v1 * c + v0 * s; v0 = o0; v1 = o1; }
                    v0 = v0 * scale; v1 = v1 * scale;
                    bf16_t* p = Q + (size_t)row * 768 + gc0 + 4 * fq;
                    *(u32x2*)p = pack4(v0); *(u32x2*)(p + 16) = pack4(v1);
                    asm volatile("" ::: "memory");
                }
        }
    }
};

struct EpiKV {
    static constexpr bool PERM = true, AFTER_DRAIN = false;
    bf16_t* Kb; bf16_t* Vb;
    __device__ __forceinline__ void operator()(f32x4 (&acc)[2][2][4][2], const Unit& u, int wr, int wc, int fr, int fq, int lane) const {
        const int row0 = u.pm * BM + wr * 64 + fr;
#pragma unroll
        for (int bj = 0; bj < 2; ++bj) {
            const int head = 2 * u.pn + bj, within = wc * 32 + 8 * fq;
            bf16_t* base = (wc < 2) ? (Kb + head * 96 + within) : (Vb + head * 64 + (within - 64));
            const int ld = (wc < 2) ? 768 : 512;
#pragma unroll
            for (int ai = 0; ai < 2; ++ai)
#pragma unroll
                for (int m = 0; m < 4; ++m) { const int row = row0 + ai * HALF + m * 16;
                    *(u32x4*)(base + (size_t)row * ld) = pack8(acc[ai][bj][m][0], acc[ai][bj][m][1]); }
        }
    }
};

struct EpiRes {
    static constexpr bool PERM = false, AFTER_DRAIN = false;
    const float* res; float* out; bf16_t* xb; float* ssqp;
    __device__ __forceinline__ void operator()(f32x4 (&acc)[2][2][4][2], const Unit& u, int wr, int wc, int fr, int fq, int lane) const {
        const int col0 = u.pn * BM + wc * 32 + 4 * fq;
#pragma unroll
        for (int ai = 0; ai < 2; ++ai)
#pragma unroll
            for (int m = 0; m < 4; ++m) {
                const int row = u.pm * BM + ai * HALF + wr * 64 + m * 16 + fr; const size_t off = (size_t)row * 1024 + col0; float ss = 0.f;
#pragma unroll
                for (int bj = 0; bj < 2; ++bj)
#pragma unroll
                    for (int n = 0; n < 2; ++n) { const size_t o = off + bj * HALF + n * 16; const f32x4 v = *(const f32x4*)(res + o) + acc[ai][bj][m][n];
                        *(f32x4*)(out + o) = v; *(u32x2*)(xb + o) = pack4(v); ss += (v[0] * v[0] + v[1] * v[1]) + (v[2] * v[2] + v[3] * v[3]); }
                ss += __shfl_xor(ss, 16); ss += __shfl_xor(ss, 32);
                if (fq == 0) ssqp[(size_t)row * 16 + u.pn * 4 + wc] = ss;
                asm volatile("" ::: "memory");
            }
    }
};

struct EpiGate {
    static constexpr bool PERM = false, AFTER_DRAIN = false;
    const float* x2; float* out; const bf16_t* pp; const float* ssq2p; float* ssq3p;
    __device__ __forceinline__ void operator()(f32x4 (&acc)[2][2][4][2], const Unit& u, int wr, int wc, int fr, int fq, int lane) const {
        const int col0 = u.pn * BM + wc * 32 + 4 * fq;
#pragma unroll
        for (int ai = 0; ai < 2; ++ai)
#pragma unroll
            for (int m = 0; m < 4; ++m) {
                const int row = u.pm * BM + ai * HALF + wr * 64 + m * 16 + fr; const size_t off = (size_t)row * 1024 + col0; float ss = 0.f;
                const float rs = rstd16(ssq2p, row);
#pragma unroll
                for (int bj = 0; bj < 2; ++bj)
#pragma unroll
                    for (int n = 0; n < 2; ++n) { const size_t o = off + bj * HALF + n * 16; const f32x4 a = acc[ai][bj][m][n] * rs; f32x4 g;
#pragma unroll
                        for (int j = 0; j < 4; ++j) g[j] = __builtin_amdgcn_rcpf(1.0f + __expf(-a[j]));
                        const f32x4 v = *(const f32x4*)(x2 + o) + g * unpack4(*(const u32x2*)(pp + o));
                        *(f32x4*)(out + o) = v; ss += (v[0] * v[0] + v[1] * v[1]) + (v[2] * v[2] + v[3] * v[3]); }
                ss += __shfl_xor(ss, 16); ss += __shfl_xor(ss, 32);
                if (fq == 0) ssq3p[(size_t)row * 16 + u.pn * 4 + wc] = ss;
                asm volatile("" ::: "memory");
            }
    }
};

__device__ __forceinline__ float dpp_ror1(float v) { return __builtin_bit_cast(float, __builtin_amdgcn_update_dpp(0, __builtin_bit_cast(int, v), 0x121, 0xf, 0xf, false)); }
__device__ __forceinline__ float dpp_ror15(float v) { return __builtin_bit_cast(float, __builtin_amdgcn_update_dpp(0, __builtin_bit_cast(int, v), 0x12F, 0xf, 0xf, false)); }
__device__ __forceinline__ f32x4 ror1v(const f32x4 v) { f32x4 r; r[0] = dpp_ror1(v[0]); r[1] = dpp_ror1(v[1]); r[2] = dpp_ror1(v[2]); r[3] = dpp_ror1(v[3]); return r; }
__device__ __forceinline__ f32x4 ror15v(const f32x4 v) { f32x4 r; r[0] = dpp_ror15(v[0]); r[1] = dpp_ror15(v[1]); r[2] = dpp_ror15(v[2]); r[3] = dpp_ror15(v[3]); return r; }
struct EpiUp {
    static constexpr bool PERM = true, AFTER_DRAIN = false;
    bf16_t* H; const float* cw; const float* cb; PG8_LAS float* halo; const PG8_LAS float* rstd;
    __device__ __forceinline__ void operator()(f32x4 (&acc)[2][2][4][2], const Unit& u, int wr, int wc, int fr, int fq, int lane) const {
        const int s = u.arow & (SEQ - 1); const bool first = (s == 0), last = (s + 256 == SEQ);
        const int ch0 = wc * 32 + 8 * fq;
#pragma unroll
        for (int ai = 0; ai < 2; ++ai)
#pragma unroll
            for (int m = 0; m < 4; ++m) { const float rs = rstd[u.ord * 256 + ai * HALF + wr * 64 + m * 16 + fr];
#pragma unroll
                for (int bj = 0; bj < 2; ++bj)
#pragma unroll
                    for (int n = 0; n < 2; ++n) acc[ai][bj][m][n] = acc[ai][bj][m][n] * rs; }
#pragma unroll
        for (int ai = 0; ai < 2; ++ai) { const int seg = 2 * ai + wr;
            if (fr == 0) {
#pragma unroll
                for (int bj = 0; bj < 2; ++bj)
#pragma unroll
                    for (int n = 0; n < 2; ++n) *(PG8_LAS f32x4*)(halo + (seg * 2 + 0) * 256 + bj * HALF + ch0 + 4 * n) = acc[ai][bj][0][n]; }
            if (fr == 15) {
#pragma unroll
                for (int bj = 0; bj < 2; ++bj)
#pragma unroll
                    for (int n = 0; n < 2; ++n) *(PG8_LAS f32x4*)(halo + (seg * 2 + 1) * 256 + bj * HALF + ch0 + 4 * n) = acc[ai][bj][3][n]; }
        }
        asm volatile("s_waitcnt lgkmcnt(0)" ::: "memory"); __builtin_amdgcn_s_barrier(); asm volatile("" ::: "memory");
        const f32x4 z4 = {0.f, 0.f, 0.f, 0.f};
#pragma unroll
        for (int n = 0; n < 2; ++n) {
            const int gch = u.pn * 128 + ch0 + 4 * n;
            const f32x4 wg0 = *(const f32x4*)(cw + gch), wg1 = *(const f32x4*)(cw + NUP + gch), wg2 = *(const f32x4*)(cw + 2 * NUP + gch), bg = *(const f32x4*)(cb + gch);
            const f32x4 wu0 = *(const f32x4*)(cw + DFF + gch), wu1 = *(const f32x4*)(cw + NUP + DFF + gch), wu2 = *(const f32x4*)(cw + 2 * NUP + DFF + gch), bu = *(const f32x4*)(cb + DFF + gch);
#pragma unroll
            for (int ai = 0; ai < 2; ++ai) {
                const int seg = 2 * ai + wr, sup = seg > 0 ? seg - 1 : 0, sdn = seg < 3 ? seg + 1 : 3;
#pragma unroll
                for (int m = 0; m < 4; ++m) {
                    const int r = ai * HALF + wr * 64 + m * 16 + fr, t = s + r;
                    f32x4 pg, pu, ng, nu;
                    if (m == 0) { pg = *(const PG8_LAS f32x4*)(halo + (sup * 2 + 1) * 256 + ch0 + 4 * n); pu = *(const PG8_LAS f32x4*)(halo + (sup * 2 + 1) * 256 + HALF + ch0 + 4 * n); }
                    else { pg = acc[ai][0][m > 0 ? m - 1 : 0][n]; pu = acc[ai][1][m > 0 ? m - 1 : 0][n]; }
                    if (m == 3) { ng = *(const PG8_LAS f32x4*)(halo + (sdn * 2 + 0) * 256 + ch0 + 4 * n); nu = *(const PG8_LAS f32x4*)(halo + (sdn * 2 + 0) * 256 + HALF + ch0 + 4 * n); }
                    else { ng = acc[ai][0][m < 3 ? m + 1 : 3][n]; nu = acc[ai][1][m < 3 ? m + 1 : 3][n]; }
                    const f32x4 vg = acc[ai][0][m][n], vu = acc[ai][1][m][n];
                    f32x4 upg = ror1v(fr == 15 ? pg : vg), upu = ror1v(fr == 15 ? pu : vu), dng = ror15v(fr == 0 ? ng : vg), dnu = ror15v(fr == 0 ? nu : vu);
                    if (t == 0) { upg = z4; upu = z4; }
                    if (t == SEQ - 1) { dng = z4; dnu = z4; }
                    const f32x4 ag = wg0 * upg + wg1 * vg + wg2 * dng + bg, au = wu0 * upu + wu1 * vu + wu2 * dnu + bu;
                    f32x4 hv;
#pragma unroll
                    for (int j = 0; j < 4; ++j) hv[j] = ag[j] * __builtin_amdgcn_rcpf(1.0f + __expf(-ag[j])) * au[j];
                    if ((r > 0 || first) && (r < 255 || last)) *(u32x2*)(H + (size_t)(u.arow + r) * DFF + u.pn * 128 + ch0 + 4 * n) = pack4(hv);
                }
            }
        }
    }
};
struct UpOrder : StaticOrder {
    __host__ __device__ void init_up(int G_, int c_) { nM = 66; nN = 22; nwg = nM * nN; G = G_; c = c_; }
    __host__ __device__ bool next(int i, Unit& u) const {
        if (!StaticOrder::next(i, u)) return false;
        const int b = u.pm / 33, k = u.pm % 33; int st = 254 * k; if (st > SEQ - 256) st = SEQ - 256;
        u.arow = b * SEQ + st; u.ord = i; return true;
    }
};
template <class Epi, class Sched, bool ALIGN_EPI = false, bool SP2 = false>
__device__ __forceinline__ void gemm_phase(PG8_LAS unsigned char* lds, const Gemm g, const Sched& S, const Epi& E) {
    const int tid = threadIdx.x, wid = __builtin_amdgcn_readfirstlane(tid >> 6), lane = tid & 63, wr = wid >> 2, wc = wid & 3, fr = lane & 15, fq = lane >> 4;
    int K_ = g.K; asm volatile("" : "+s"(K_));
    const int K = K_, nt = K / BK;
    unsigned voffA[2], voffB[2];
#pragma unroll
    for (int i = 0; i < 2; ++i) { int R, C; stage_rc(tid * 16 + i * 8192, R, C); const int Rb = Epi::PERM ? ((R & ~31) + perm32(R & 31)) : R;
        voffA[i] = (unsigned)(R * K + C) * 2u; voffB[i] = (unsigned)(Rb * K + C) * 2u; }
    const size_t kstep = (size_t)(BK * 2);
    const size_t hstep = (size_t)HALF * K * 2;
    const size_t rstep = (size_t)K * 2;
    const size_t tstep = 2 * hstep;
    const unsigned ldsw = (unsigned)wid * 1024u;
    const int aoff = lds_byte(wr * 64 + fr, fq * 8), boff = lds_byte(wc * 32 + fr, fq * 8);
#define PG8_SA(b, h) (((b) * 2 + (h)) * HTB)
#define PG8_SB(b, h) ((4 + (b) * 2 + (h)) * HTB)
#define PG8_STAGE(bufoff, gbase, voff) do { _Pragma("unroll") for (int _i = 0; _i < 2; ++_i) \
        __builtin_amdgcn_global_load_lds((const unsigned*)((const char*)(gbase) + (voff)[_i]), (PG8_LAS unsigned*)(lds + (bufoff) + ldsw + _i * 8192), 16, 0, 0); } while (0)
#define PG8_LDA(dst, b, h) do { _Pragma("unroll") for (int m = 0; m < 4; ++m) _Pragma("unroll") for (int k = 0; k < 2; ++k) dst[m][k] = *(const PG8_LAS bf16x8*)(lds + PG8_SA(b, h) + aoff + m * 2048 + k * 1024); } while (0)
#define PG8_LDB(dst, b, h) do { _Pragma("unroll") for (int n = 0; n < 2; ++n) _Pragma("unroll") for (int k = 0; k < 2; ++k) dst[n][k] = *(const PG8_LAS bf16x8*)(lds + PG8_SB(b, h) + boff + n * 2048 + k * 1024); } while (0)
#define PG8_MMA(ai, bj, At, Bt) do { __builtin_amdgcn_s_setprio(1); _Pragma("unroll") for (int m = 0; m < 4; ++m) _Pragma("unroll") for (int n = 0; n < 2; ++n) _Pragma("unroll") for (int k = 0; k < 2; ++k) \
        acc[ai][bj][m][n] = __builtin_amdgcn_mfma_f32_16x16x32_bf16(Bt[n][k], At[m][k], acc[ai][bj][m][n], 0, 0, 0); __builtin_amdgcn_s_setprio(0); } while (0)
#define PG8_WAIT_V(n) asm volatile("s_waitcnt vmcnt(" #n ")" ::: "memory")
#define PG8_WAIT_L(n) asm volatile("s_waitcnt lgkmcnt(" #n ")" ::: "memory")
#define PG8_BAR __builtin_amdgcn_s_barrier()
#define PG8_SCHED __builtin_amdgcn_sched_barrier(0)
    Unit cur, nxt; int ui = 0;
    if (!S.next(0, cur)) return;
    f32x4 acc[2][2][4][2];
#pragma unroll
    for (int a = 0; a < 2; ++a)
#pragma unroll
        for (int b = 0; b < 2; ++b)
#pragma unroll
            for (int m = 0; m < 4; ++m)
#pragma unroll
                for (int n = 0; n < 2; ++n) acc[a][b][m][n] = (f32x4){0.f, 0.f, 0.f, 0.f};
    bf16x8 At[4][2], B0[2][2], B1[2][2];
    const char* cA = (const char*)g.A + (size_t)cur.arow * rstep; const char* cB = (const char*)g.Bt + (size_t)cur.pn * tstep;
    S.a_ready(cur);
    if constexpr (SP2) {
        PG8_STAGE(PG8_SB(0, 0), cB, voffB); PG8_STAGE(PG8_SB(0, 1), cB + hstep, voffB); PG8_STAGE(PG8_SA(0, 0), cA, voffA); PG8_STAGE(PG8_SA(0, 1), cA + hstep, voffA);
        if (wr == 1) PG8_BAR;
        PG8_WAIT_V(2); PG8_BAR;
        PG8_STAGE(PG8_SB(1, 0), cB + kstep, voffB); PG8_STAGE(PG8_SA(1, 0), cA + kstep, voffA); PG8_STAGE(PG8_SB(1, 1), cB + hstep + kstep, voffB);
        PG8_WAIT_V(6); PG8_BAR;
    } else {
        PG8_STAGE(PG8_SB(0, 0), cB, voffB); PG8_STAGE(PG8_SA(0, 0), cA, voffA); PG8_STAGE(PG8_SB(0, 1), cB + hstep, voffB); PG8_STAGE(PG8_SA(0, 1), cA + hstep, voffA);
        if (wr == 1) PG8_BAR;
        PG8_WAIT_V(4); PG8_BAR;
        PG8_STAGE(PG8_SB(1, 0), cB + kstep, voffB); PG8_STAGE(PG8_SA(1, 0), cA + kstep, voffA); PG8_STAGE(PG8_SB(1, 1), cB + hstep + kstep, voffB);
        PG8_WAIT_V(6); PG8_BAR;
    }
    for (;;) {
        const bool has_next = S.next(ui + 1, nxt);
        const char* nA = has_next ? (const char*)g.A + (size_t)nxt.arow * rstep : cA; const char* nB = has_next ? (const char*)g.Bt + (size_t)nxt.pn * tstep : cB;
        for (int t = 0; t < nt; t += 2) {
            const bool last = (t == nt - 2);
            const char* a1 = cA + (size_t)(t + 1) * kstep;
            const char* a2 = last ? nA : cA + (size_t)(t + 2) * kstep; const char* b2 = last ? nB : cB + (size_t)(t + 2) * kstep;
            const char* a3 = a2 + kstep; const char* b3 = b2 + kstep;
            if (last && has_next) S.a_ready(nxt);
            if constexpr (SP2) {
            PG8_LDB(B0, 0, 0); PG8_LDB(B1, 0, 1); PG8_SCHED; PG8_LDA(At, 0, 0); PG8_STAGE(PG8_SA(1, 1), a1 + hstep, voffA);
            PG8_WAIT_V(8); PG8_WAIT_L(0); PG8_BAR; PG8_MMA(0, 0, At, B0); PG8_MMA(0, 1, At, B1); PG8_BAR; PG8_SCHED;
            PG8_LDA(At, 0, 1); PG8_STAGE(PG8_SB(0, 0), b2, voffB); PG8_STAGE(PG8_SB(0, 1), b2 + hstep, voffB); PG8_STAGE(PG8_SA(0, 0), a2, voffA);
            PG8_WAIT_V(8); PG8_WAIT_L(0); PG8_BAR; PG8_MMA(1, 0, At, B0); PG8_MMA(1, 1, At, B1); PG8_BAR; PG8_SCHED;
            PG8_LDB(B0, 1, 0); PG8_LDB(B1, 1, 1); PG8_SCHED; PG8_LDA(At, 1, 0); PG8_STAGE(PG8_SA(0, 1), a2 + hstep, voffA);
            PG8_WAIT_V(8); PG8_WAIT_L(0); PG8_BAR; PG8_MMA(0, 0, At, B0); PG8_MMA(0, 1, At, B1); PG8_BAR; PG8_SCHED;
            PG8_LDA(At, 1, 1); PG8_STAGE(PG8_SB(1, 0), b3, voffB); PG8_STAGE(PG8_SB(1, 1), b3 + hstep, voffB); PG8_STAGE(PG8_SA(1, 0), a3, voffA);
            PG8_WAIT_V(8); PG8_WAIT_L(0); PG8_BAR; PG8_MMA(1, 0, At, B0); PG8_MMA(1, 1, At, B1); PG8_BAR; PG8_SCHED;
            } else {
            PG8_LDB(B0, 0, 0); PG8_SCHED; PG8_LDA(At, 0, 0); PG8_STAGE(PG8_SA(1, 1), a1 + hstep, voffA);
            PG8_WAIT_L(8); PG8_BAR; PG8_WAIT_L(0); PG8_MMA(0, 0, At, B0); PG8_BAR; PG8_SCHED;
            PG8_LDB(B1, 0, 1); PG8_STAGE(PG8_SB(0, 0), b2, voffB);
            PG8_BAR; PG8_WAIT_L(0); PG8_MMA(0, 1, At, B1); PG8_BAR;
            PG8_LDA(At, 0, 1); PG8_STAGE(PG8_SA(0, 0), a2, voffA);
            PG8_BAR; PG8_WAIT_L(0); PG8_MMA(1, 0, At, B0); PG8_BAR; PG8_SCHED;
            PG8_STAGE(PG8_SB(0, 1), b2 + hstep, voffB);
            PG8_WAIT_V(6); PG8_BAR; PG8_MMA(1, 1, At, B1); PG8_BAR;
            PG8_LDB(B0, 1, 0); PG8_SCHED; PG8_LDA(At, 1, 0); PG8_STAGE(PG8_SA(0, 1), a2 + hstep, voffA);
            PG8_WAIT_L(8); PG8_BAR; PG8_WAIT_L(0); PG8_MMA(0, 0, At, B0); PG8_BAR; PG8_SCHED;
            PG8_LDB(B1, 1, 1); PG8_STAGE(PG8_SB(1, 0), b3, voffB);
            PG8_BAR; PG8_WAIT_L(0); PG8_MMA(0, 1, At, B1); PG8_BAR;
            PG8_LDA(At, 1, 1); PG8_STAGE(PG8_SA(1, 0), a3, voffA);
            PG8_BAR; PG8_WAIT_L(0); PG8_MMA(1, 0, At, B0); PG8_BAR; PG8_SCHED;
            PG8_STAGE(PG8_SB(1, 1), b3 + hstep, voffB);
            PG8_WAIT_V(6); PG8_BAR; PG8_MMA(1, 1, At, B1); PG8_BAR;
            }
        }
        if constexpr (ALIGN_EPI) { if (wr == 0) PG8_BAR; }
        if constexpr (!Epi::AFTER_DRAIN) { E(acc, cur, wr, wc, fr, fq, lane); S.done(cur); }
        if (!has_next) break;
#pragma unroll
        for (int a = 0; a < 2; ++a)
#pragma unroll
            for (int b = 0; b < 2; ++b)
#pragma unroll
                for (int m = 0; m < 4; ++m)
#pragma unroll
                    for (int n = 0; n < 2; ++n) acc[a][b][m][n] = (f32x4){0.f, 0.f, 0.f, 0.f};
        cur = nxt; cA = nA; cB = nB; ++ui;
        if constexpr (ALIGN_EPI) { if (wr == 1) PG8_BAR; }
    }
    PG8_WAIT_V(0);
    if constexpr (!ALIGN_EPI) { if (wr == 0) PG8_BAR; }
    PG8_BAR;
    if constexpr (Epi::AFTER_DRAIN) { E.fused(acc, cur, wr, wc, fr, fq, lds, wid, lane); S.done(cur); }
#undef PG8_SA
#undef PG8_SB
#undef PG8_STAGE
#undef PG8_LDA
#undef PG8_LDB
#undef PG8_MMA
#undef PG8_WAIT_V
#undef PG8_WAIT_L
#undef PG8_BAR
#undef PG8_SCHED
}
}
namespace attn {
using bf16x8 = __attribute__((ext_vector_type(8))) short;
using s16x4  = __attribute__((ext_vector_type(4))) short;
using f32x16 = __attribute__((ext_vector_type(16))) float;
using u32x4  = __attribute__((ext_vector_type(4))) unsigned;
typedef unsigned short bf16_t;
constexpr int NW = 8, QBLK = 32, KVBLK = 64, KROW = 208;
constexpr int SHM_V = KVBLK * 64 * 2, SHM_K = KVBLK * KROW, LDS_WS = 2 * SHM_V + 2 * SHM_K, LDS_BYTES = LDS_WS + NW * 64 * 4;
constexpr float THR = 8.f;
#define ASBAR() __builtin_amdgcn_sched_barrier(0)
__device__ __forceinline__ int crow(int r, int hi) { return (r & 3) + 8 * (r >> 2) + 4 * hi; }
__device__ __forceinline__ unsigned cvtpk(float lo, float hi) { unsigned r; asm volatile("v_cvt_pk_bf16_f32 %0, %1, %2" : "=v"(r) : "v"(lo), "v"(hi)); return r; }

__device__ __forceinline__ void partialSM(f32x16& p0, f32x16& p1, float& m_reg, float& alpha) {
  float pmax = p0[0];
#pragma unroll
  for (int r = 1; r < 16; ++r) pmax = fmaxf(pmax, p0[r]);
#pragma unroll
  for (int r = 0; r < 16; ++r) pmax = fmaxf(pmax, p1[r]);
  { auto rr = __builtin_amdgcn_permlane32_swap(__float_as_uint(pmax), __float_as_uint(pmax), false, false);
    pmax = fmaxf(__uint_as_float(rr[0]), __uint_as_float(rr[1])); }
  float mn;
  if (__builtin_expect(__all(pmax - m_reg <= THR), 1)) { mn = m_reg; alpha = 1.f; }
  else { mn = fmaxf(m_reg, pmax); alpha = __builtin_amdgcn_exp2f(m_reg - mn); m_reg = mn; }
#pragma unroll
  for (int r = 0; r < 16; ++r) p0[r] = p0[r] - mn;
#pragma unroll
  for (int r = 0; r < 16; ++r) p1[r] = p1[r] - mn;
#pragma unroll
  for (int r = 0; r < 16; ++r) p0[r] = __builtin_amdgcn_exp2f(p0[r]);
}
__device__ __forceinline__ void finishSM(f32x16& p0, f32x16& p1, float alpha, float& l_reg, bf16x8& pa0, bf16x8& pa1, bf16x8& pa2, bf16x8& pa3) {
#pragma unroll
  for (int r = 0; r < 16; ++r) p1[r] = __builtin_amdgcn_exp2f(p1[r]);
  float ps = 0;
#pragma unroll
  for (int r = 0; r < 16; ++r) ps += p0[r];
#pragma unroll
  for (int r = 0; r < 16; ++r) ps += p1[r];
  { auto rr = __builtin_amdgcn_permlane32_swap(__float_as_uint(ps), __float_as_uint(ps), false, false);
    ps = __uint_as_float(rr[0]) + __uint_as_float(rr[1]); }
  l_reg = l_reg * alpha + ps;
#define PK4(P, BASE, OUT) do { unsigned a0 = cvtpk(P[BASE + 0], P[BASE + 1]), a1 = cvtpk(P[BASE + 2], P[BASE + 3]);   \
    unsigned b0 = cvtpk(P[BASE + 4], P[BASE + 5]), b1 = cvtpk(P[BASE + 6], P[BASE + 7]);                              \
    auto r0 = __builtin_amdgcn_permlane32_swap(a0, b0, false, false); auto r1 = __builtin_amdgcn_permlane32_swap(a1, b1, false, false); \
    u32x4 w = {r0[0], r1[0], r0[1], r1[1]}; OUT = *reinterpret_cast<bf16x8*>(&w); } while (0)
  PK4(p0, 0, pa0); PK4(p0, 8, pa1); PK4(p1, 0, pa2); PK4(p1, 8, pa3);
#undef PK4
}
__device__ __forceinline__ void qkt(f32x16& p0, f32x16& p1, const char* Ks, const bf16x8* qr, int r32, int hi) {
  p0 = f32x16{}; p1 = f32x16{};
#pragma unroll
  for (int d0 = 0; d0 < 6; ++d0) { const int cb = (d0 * 16 + hi * 8) * 2;
    const bf16x8 b0 = *reinterpret_cast<const bf16x8*>(Ks + r32 * KROW + cb);
    const bf16x8 b1 = *reinterpret_cast<const bf16x8*>(Ks + (32 + r32) * KROW + cb);
    p0 = __builtin_amdgcn_mfma_f32_32x32x16_bf16(b0, qr[d0], p0, 0, 0, 0);
    p1 = __builtin_amdgcn_mfma_f32_32x32x16_bf16(b1, qr[d0], p1, 0, 0, 0); }
}
__device__ __forceinline__ int v_st(int k, int c) { const int kk = (k & ~0xC) | ((k & 4) << 1) | ((k & 8) >> 1); return ((kk >> 3) * 2 + (c >> 5)) * 512 + ((kk & 7) * 32 + (c & 31)) * 2; }
__device__ __forceinline__ int v_rd_base(int lane) { return ((lane & 3) << 3) | (((lane >> 2) & 3) << 6) | (((lane >> 4) & 1) << 5) | (((lane >> 5) & 1) << 8); }
constexpr int v_rd_off(int d0, int ks, int half) { return d0 * 512 + ks * 2048 + half * 1024; }
template <int OFF> __device__ __forceinline__ s16x4 tr_read(int vb) {
  s16x4 r; asm volatile("ds_read_b64_tr_b16 %0, %1 offset:%2" : "=&v"(r) : "v"(vb), "i"(OFF) : "memory"); return r;
}
template <int D0> __device__ __forceinline__ void pv_one(f32x16& od, int vb, bf16x8 pa0, bf16x8 pa1, bf16x8 pa2, bf16x8 pa3) {
  const s16x4 l0 = tr_read<v_rd_off(D0, 0, 0)>(vb), h0 = tr_read<v_rd_off(D0, 0, 1)>(vb), l1 = tr_read<v_rd_off(D0, 1, 0)>(vb), h1 = tr_read<v_rd_off(D0, 1, 1)>(vb);
  const s16x4 l2 = tr_read<v_rd_off(D0, 2, 0)>(vb), h2 = tr_read<v_rd_off(D0, 2, 1)>(vb), l3 = tr_read<v_rd_off(D0, 3, 0)>(vb), h3 = tr_read<v_rd_off(D0, 3, 1)>(vb);
  asm volatile("s_waitcnt lgkmcnt(0)" ::: "memory"); ASBAR();
#define PK(L, H) (bf16x8){L[0], L[1], L[2], L[3], H[0], H[1], H[2], H[3]}
  od = __builtin_amdgcn_mfma_f32_32x32x16_bf16(pa0, PK(l0, h0), od, 0, 0, 0);
  od = __builtin_amdgcn_mfma_f32_32x32x16_bf16(pa1, PK(l1, h1), od, 0, 0, 0);
  od = __builtin_amdgcn_mfma_f32_32x32x16_bf16(pa2, PK(l2, h2), od, 0, 0, 0);
  od = __builtin_amdgcn_mfma_f32_32x32x16_bf16(pa3, PK(l3, h3), od, 0, 0, 0);
#undef PK
}
__device__ __forceinline__ void pv_d0(f32x16* o, int vb, bf16x8 pa0, bf16x8 pa1, bf16x8 pa2, bf16x8 pa3) {
  pv_one<0>(o[0], vb, pa0, pa1, pa2, pa3); pv_one<1>(o[1], vb, pa0, pa1, pa2, pa3);
}
__device__ __forceinline__ void attn_unit(const bf16_t* __restrict__ Qb, const bf16_t* __restrict__ Kh, const bf16_t* __restrict__ Vh, bf16_t* __restrict__ Ob, int seq, char* lds) {
  const int tid = threadIdx.x, wid = __builtin_amdgcn_readfirstlane(tid >> 6), lane = tid & 63, r32 = lane & 31, hi = lane >> 5;
  char* V_lds = lds; char* K_lds = lds + 2 * SHM_V;
  float* ws = (float*)(lds + LDS_WS) + wid * 64; float* li_l = ws; float* al_l = ws + 32;
  float m_reg = -1e30f, l_reg = 0; f32x16 o[2] = {}; bf16x8 qr[6];
  const bf16_t* Qw = Qb + (long)(wid * QBLK + r32) * 768 + hi * 8;
#pragma unroll
  for (int d0 = 0; d0 < 6; ++d0) qr[d0] = *reinterpret_cast<const bf16x8*>(Qw + d0 * 16);
  const int vrow = tid >> 3, vcol = (tid & 7) * 8, vst = v_st(vrow, vcol);
  const int kr0 = tid / 12, kc0 = tid % 12, kr1 = (512 + (tid & 255)) / 12, kc1 = (512 + (tid & 255)) % 12;
  const bool k2 = wid < 4;
  const int vb0 = (int)(uintptr_t)V_lds + v_rd_base(lane);
  struct { bf16x8 vs, ks0, ks1; } sr_[2];
#define SLOAD(i, k0) do { sr_[i].vs = *reinterpret_cast<const bf16x8*>(&Vh[(long)((k0) + vrow) * 512 + vcol]); \
    sr_[i].ks0 = *reinterpret_cast<const bf16x8*>(&Kh[(long)((k0) + kr0) * 768 + kc0 * 8]); \
    if (k2) sr_[i].ks1 = *reinterpret_cast<const bf16x8*>(&Kh[(long)((k0) + kr1) * 768 + kc1 * 8]); } while (0)
#define SWRITE(b, i) do { *(bf16x8*)(V_lds + (b) * SHM_V + vst) = sr_[i].vs; \
    *(bf16x8*)(K_lds + (b) * SHM_K + kr0 * KROW + kc0 * 16) = sr_[i].ks0; \
    if (k2) *(bf16x8*)(K_lds + (b) * SHM_K + kr1 * KROW + kc1 * 16) = sr_[i].ks1; } while (0)
#define SWAIT() do { if (k2) asm volatile("s_waitcnt vmcnt(3)" ::: "memory"); else asm volatile("s_waitcnt vmcnt(2)" ::: "memory"); } while (0)
#define RESC(a) do { if (__any((a) < 1.f)) { if (hi == 0) al_l[r32] = (a); asm volatile("s_waitcnt lgkmcnt(0)" ::: "memory"); \
    _Pragma("unroll") for (int d = 0; d < 2; ++d) _Pragma("unroll") for (int r = 0; r < 16; ++r) o[d][r] *= al_l[crow(r, hi)]; } } while (0)
  f32x16 pA0, pA1, pB0, pB1; float alA, alB; bf16x8 pa0, pa1, pa2, pa3; const int NT = seq / KVBLK;
  constexpr int SE = 0, SO = 1;
  SLOAD(SE, 0); asm volatile("s_waitcnt vmcnt(0)" ::: "memory"); SWRITE(0, SE); __syncthreads();
  qkt(pA0, pA1, K_lds, qr, r32, hi); partialSM(pA0, pA1, m_reg, alA);
  SLOAD(SO, KVBLK); if (2 < NT) SLOAD(SE, 2 * KVBLK);
  SWAIT(); SWRITE(1, SO); __syncthreads();
  for (int j = 1; j + 1 < NT; j += 2) {
    ASBAR(); qkt(pB0, pB1, K_lds + SHM_K, qr, r32, hi);
    finishSM(pA0, pA1, alA, l_reg, pa0, pa1, pa2, pa3); ASBAR();
    SLOAD(SO, (j + 2) * KVBLK); ASBAR();
    pv_d0(o, vb0, pa0, pa1, pa2, pa3); partialSM(pB0, pB1, m_reg, alB);
    __syncthreads(); SWAIT(); SWRITE(0, SE);
    RESC(alB); __syncthreads();
    ASBAR(); qkt(pA0, pA1, K_lds, qr, r32, hi);
    finishSM(pB0, pB1, alB, l_reg, pa0, pa1, pa2, pa3); ASBAR();
    if (j + 3 < NT) SLOAD(SE, (j + 3) * KVBLK); ASBAR();
    pv_d0(o, vb0 + SHM_V, pa0, pa1, pa2, pa3); partialSM(pA0, pA1, m_reg, alA);
    __syncthreads(); SWAIT(); SWRITE(1, SO);
    RESC(alA); __syncthreads();
  }
  ASBAR(); qkt(pB0, pB1, K_lds + SHM_K, qr, r32, hi);
  finishSM(pA0, pA1, alA, l_reg, pa0, pa1, pa2, pa3); ASBAR();
  pv_d0(o, vb0, pa0, pa1, pa2, pa3); partialSM(pB0, pB1, m_reg, alB);
  __syncthreads(); RESC(alB);
  finishSM(pB0, pB1, alB, l_reg, pa0, pa1, pa2, pa3); ASBAR();
  pv_d0(o, vb0 + SHM_V, pa0, pa1, pa2, pa3);
  if (hi == 0) li_l[r32] = l_reg; asm volatile("s_waitcnt lgkmcnt(0)" ::: "memory");
  float rli[16];
#pragma unroll
  for (int r = 0; r < 16; ++r) rli[r] = __builtin_amdgcn_rcpf(li_l[crow(r, hi)]);
  bf16_t* Ow = Ob + (long)(wid * QBLK) * 1024;
#pragma unroll
  for (int r = 0; r < 16; ++r) { const int orow = crow(r, hi);
#pragma unroll
    for (int d0 = 0; d0 < 2; ++d0) Ow[(long)orow * 1024 + d0 * 32 + r32] = (bf16_t)(cvtpk(o[d0][r] * rli[r], 0.f) & 0xffffu); }
  __syncthreads();
#undef SLOAD
#undef SWRITE
#undef SWAIT
#undef RESC
}
#undef ASBAR
}
#define GAS __attribute__((address_space(1)))
#define LAS __attribute__((address_space(3)))
typedef unsigned short bf16;
typedef unsigned v4u __attribute__((ext_vector_type(4)));
typedef float f32x4 __attribute__((ext_vector_type(4)));
typedef short bf16x8 __attribute__((ext_vector_type(8)));
typedef GAS unsigned gu32;
typedef GAS unsigned long long gu64;
#define RLX_AGENT __ATOMIC_RELAXED, __HIP_MEMORY_SCOPE_AGENT
#define LDS_WAIT() asm volatile("s_waitcnt lgkmcnt(0)" ::: "memory")
#define VM_WAIT() asm volatile("s_waitcnt vmcnt(0)" ::: "memory")
__device__ __forceinline__ unsigned long long rt() { return __builtin_amdgcn_s_memrealtime(); }
__device__ __forceinline__ unsigned f2bf(float f) { unsigned u = __builtin_bit_cast(unsigned, f); return (u + 0x7fffu + ((u >> 16) & 1u)) >> 16; }
__device__ __forceinline__ unsigned pk2(float lo, float hi) { return f2bf(lo) | (f2bf(hi) << 16); }

#define XB_TMO      128
#define XB_XCNT(j)  (256  + 64 * (j))
#define XB_XSUB(j)  (1280 + 64 * (j))
#define XB_XGEN(j)  (2304 + 64 * (j))
#define XB_TOP      3328
#define XB_TOPGEN   3392
#define XCD_BAR_WORDS 3456
#define XB_SPIN_CAP (1u << 18)

__device__ __forceinline__ unsigned xb_ld(unsigned* p)              { return __hip_atomic_load(p, __ATOMIC_RELAXED, __HIP_MEMORY_SCOPE_AGENT); }
__device__ __forceinline__ unsigned xb_add(unsigned* p, unsigned v) { return __hip_atomic_fetch_add(p, v, __ATOMIC_RELAXED, __HIP_MEMORY_SCOPE_AGENT); }
__device__ __forceinline__ unsigned xb_xcc_id() { return (unsigned)__builtin_amdgcn_s_getreg((3 << 11) | 20) & 0xFu; }
#define XB_SPIN(cond, bar) do { unsigned _sp = 0; while (cond) { __builtin_amdgcn_s_sleep(1); \
    if ((++_sp & 255u) == 0u) { if (xb_ld(&(bar)[XB_TMO])) break; if (_sp > XB_SPIN_CAP) { atomicAdd(&(bar)[XB_TMO], 1u); break; } } } } while (0)

struct XcdBarrier {
    unsigned* bar; unsigned x;
    volatile LAS unsigned* st;
};

__device__ __forceinline__ XcdBarrier xcd_barrier_post(unsigned* bar, volatile LAS unsigned* st) {
    XcdBarrier b; b.bar = bar; b.x = xb_xcc_id(); b.st = st;
    if (threadIdx.x == 0) (void)xb_add(&bar[XB_XCNT(b.x)], 1u);
    return b;
}
__device__ __forceinline__ void xcd_barrier_complete(unsigned* bar, unsigned x, unsigned& nloc, unsigned& nx) {
    const unsigned G = gridDim.x * gridDim.y * gridDim.z;
    unsigned sum, cnt, mine, sp = 0u;
    for (;;) {
        sum = 0u; cnt = 0u; mine = 0u;
#pragma unroll
        for (unsigned j = 0; j < 16; ++j) { const unsigned c = xb_ld(&bar[XB_XCNT(j)]); sum += c; cnt += (c > 0u) ? 1u : 0u; mine = (j == x) ? c : mine; }
        if (sum == G) break;
        __builtin_amdgcn_s_sleep(1);
        if ((++sp & 255u) == 0u) { if (xb_ld(&bar[XB_TMO])) break; if (sp > XB_SPIN_CAP) { atomicAdd(&bar[XB_TMO], 1u); break; } }
    }
    nloc = mine > 0u ? mine : 1u; nx = cnt > 0u ? cnt : 1u;
}

__device__ __forceinline__ void xcd_barrier(const XcdBarrier& b) {
    asm volatile("s_waitcnt vmcnt(0)" ::: "memory");
    __syncthreads();
    if (threadIdx.x == 0) {
        unsigned* bar = b.bar;
        __builtin_amdgcn_s_waitcnt(0);
        unsigned nloc = b.st[0], nx = b.st[1];
        if (nloc == 0u) { xcd_barrier_complete(bar, b.x, nloc, nx); b.st[0] = nloc; b.st[1] = nx; }
        const unsigned old = xb_add(&bar[XB_XSUB(b.x)], 1u);
        const unsigned gen = old / nloc;
        if (old + 1u == (gen + 1u) * nloc) {
            __builtin_amdgcn_fence(__ATOMIC_RELEASE, "agent");
            asm volatile("s_waitcnt vmcnt(0)" ::: "memory");
            const unsigned og = xb_add(&bar[XB_TOP], 1u);
            const unsigned tg = og / nx;
            if (og + 1u == (tg + 1u) * nx) xb_add(&bar[XB_TOPGEN], 1u);
            else XB_SPIN(xb_ld(&bar[XB_TOPGEN]) == tg, bar);
            __builtin_amdgcn_fence(__ATOMIC_ACQUIRE, "agent");
            xb_add(&bar[XB_XGEN(b.x)], 1u);
            asm volatile("s_waitcnt vmcnt(0)" ::: "memory");
        } else {
            XB_SPIN(xb_ld(&bar[XB_XGEN(b.x)]) == gen, bar);
            __builtin_amdgcn_fence(__ATOMIC_ACQUIRE, "agent");
            asm volatile("s_waitcnt vmcnt(0)" ::: "memory");
        }
    }
    __syncthreads();
}

constexpr int NWAVES = 8;
#ifndef MK_N_LAUNCHES
#define MK_N_LAUNCHES 1
#endif
constexpr int N_PHASES = 10;
constexpr int N_LAUNCHES = MK_N_LAUNCHES;

constexpr size_t MiB = 1u << 20;
constexpr size_t WS_CTL = 0, CTL_ZERO_BYTES = 65536;
constexpr size_t WS_COS = 1 * MiB, WS_SIN = 1 * MiB + 512 * 1024;
constexpr size_t WS_SSQ1 = 2 * MiB, WS_SSQ2 = 3 * MiB, WS_SSQ3 = 4 * MiB;
constexpr size_t WS_W1 = 5 * MiB;
constexpr size_t WS_WUQ = 9 * MiB;
constexpr size_t WS_WUKV = 9 * MiB + 512 * 1024;
constexpr size_t WS_WO = 10 * MiB;
constexpr size_t WS_WUP = 12 * MiB;
constexpr size_t WS_WDN = 23 * MiB;
constexpr size_t WS_WG = 29 * MiB;
constexpr size_t WS_WPJ = 31 * MiB;
constexpr size_t WS_HB = 32 * MiB;
constexpr size_t WS_Z = 64 * MiB;
constexpr size_t WS_Q = 128 * MiB;
constexpr size_t WS_K = 152 * MiB;
constexpr size_t WS_V = 176 * MiB;
constexpr size_t WS_XB = 152 * MiB;
constexpr size_t WS_QN = 192 * MiB, WS_KVN = 200 * MiB, WS_PB = 208 * MiB;
constexpr size_t WS_PP = 216 * MiB;
constexpr size_t WS_END = 248 * MiB;
static_assert(WS_Z + (size_t)M * DFF * 2 <= WS_K && WS_WDN + (size_t)DM * DFF * 2 <= WS_WG, "d_ws map");
constexpr int CW_BAR = 1024;

constexpr int RING_OFF = 0, RING_BYTES = 131072;
constexpr int MISC_OFF = RING_BYTES, HALO_OFF = RING_BYTES + 512, RSTD_OFF = HALO_OFF + 8192;
constexpr int LDS_BYTES = 147456;
static_assert(RSTD_OFF + 6 * 1024 <= LDS_BYTES, "LDS map");

struct Frame {
    LAS unsigned char* lds;
    int tid, lane, wave, vcu, G;
};

__device__ __forceinline__ float wave_sum(float v) {
#pragma unroll
    for (int o = 1; o < 64; o <<= 1) v += __shfl_xor(v, o);
    return v;
}
template <int MAP>
__device__ __forceinline__ void transpose_item(const float* W, int K, int N, bf16* WT, int ldk, const float* gain, LAS float* scr, int item, int lane) {
    const int nblk = N / 32, kb = item / nblk, nb = item % nblk, k0 = 64 * kb, n0 = 32 * nb;
#pragma unroll 8
    for (int i = 0; i < 32; ++i) { const int kk = 2 * i + (lane >> 5); float v = W[(size_t)(k0 + kk) * N + n0 + (lane & 31)]; if (gain) v *= gain[k0 + kk]; scr[kk * 33 + (lane & 31)] = v; }
    LDS_WAIT(); asm volatile("" ::: "memory");
    int r0 = n0;
    if (MAP == 1) { r0 = (n0 < DFF) ? (256 * (n0 / 128) + (n0 % 128)) : (256 * ((n0 - DFF) / 128) + 128 + ((n0 - DFF) % 128)); }
    const int c = lane & 7;
#pragma unroll
    for (int j = 0; j < 4; ++j) { const int n = (lane >> 3) + 8 * j; const LAS float* s = scr + (8 * c) * 33 + n;
        v4u o; o.x = pk2(s[0 * 33], s[1 * 33]); o.y = pk2(s[2 * 33], s[3 * 33]); o.z = pk2(s[4 * 33], s[5 * 33]); o.w = pk2(s[6 * 33], s[7 * 33]);
        *(GAS v4u*)(WT + (size_t)(r0 + n) * ldk + k0 + 8 * c) = o; }
    LDS_WAIT(); asm volatile("" ::: "memory");
}

struct Ptrs {
    const float *x, *p, *g_mix, *w_in, *conv_w, *g_q, *w_uq, *g_kv, *w_ukv, *w_o, *g_ffn, *w_up, *fcw, *fcb, *w_down, *g_ple, *w_gate, *w_proj, *g_final;
    float* out; unsigned char* ws;
};

__device__ __forceinline__ void p0_prologue(Frame& F, const Ptrs& P) {
    unsigned char* ws = P.ws;
    LAS float* scr = (LAS float*)(F.lds + RING_OFF + F.wave * 16384);
    const int gw = F.vcu * NWAVES + F.wave, NGW = F.G * NWAVES;
    constexpr int I_W1 = (DM / 64) * (DIN / 32), I_UQ = (QLORA / 64) * (768 / 32), I_UKV = (KVLORA / 64) * (1024 / 32), I_O = (DM / 64) * (DM / 32),
                  I_UP = (DM / 64) * (NUP / 32), I_DN = (DFF / 64) * (DM / 32), I_G = I_O, I_PJ = (PLE / 64) * (DM / 32);
    constexpr int NITEMS = I_W1 + I_UQ + I_UKV + I_O + I_UP + I_DN + I_G + I_PJ;
    for (int it = gw; it < NITEMS; it += NGW) {
        int r = it;
        if (r < I_UP) { transpose_item<1>(P.w_up, DM, NUP, (bf16*)(ws + WS_WUP), DM, P.g_ffn, scr, r, F.lane); continue; } r -= I_UP;
        if (r < I_DN) { transpose_item<0>(P.w_down, DFF, DM, (bf16*)(ws + WS_WDN), DFF, nullptr, scr, r, F.lane); continue; } r -= I_DN;
        if (r < I_W1) { transpose_item<0>(P.w_in, DM, DIN, (bf16*)(ws + WS_W1), DM, P.g_mix, scr, r, F.lane); continue; } r -= I_W1;
        if (r < I_O) { transpose_item<0>(P.w_o, DM, DM, (bf16*)(ws + WS_WO), DM, nullptr, scr, r, F.lane); continue; } r -= I_O;
        if (r < I_G) { transpose_item<0>(P.w_gate, DM, DM, (bf16*)(ws + WS_WG), DM, P.g_ple, scr, r, F.lane); continue; } r -= I_G;
        if (r < I_PJ) { transpose_item<0>(P.w_proj, PLE, DM, (bf16*)(ws + WS_WPJ), PLE, nullptr, scr, r, F.lane); continue; } r -= I_PJ;
        if (r < I_UQ) { transpose_item<0>(P.w_uq, QLORA, 768, (bf16*)(ws + WS_WUQ), QLORA, P.g_q, scr, r, F.lane); continue; } r -= I_UQ;
        transpose_item<0>(P.w_ukv, KVLORA, 1024, (bf16*)(ws + WS_WUKV), 256, P.g_kv, scr, r, F.lane);
    }
    const int gt = F.vcu * (NWAVES * 64) + F.tid, NGT = F.G * NWAVES * 64;
    const v4u zero4 = {0u, 0u, 0u, 0u};
    for (int i = gt; i < 12288; i += NGT) *(GAS v4u*)(ws + WS_W1 + (size_t)DIN * DM * 2 + (size_t)i * 16) = zero4;
    for (int i = gt; i < 16384; i += NGT) *(GAS v4u*)(ws + WS_WUKV + (size_t)(i >> 4) * 512 + 256 + (size_t)(i & 15) * 16) = zero4;
    for (int i = gt; i < SEQ * 16; i += NGT) {
        const int pos = i >> 4, j = i & 15;
        constexpr float INVF[16] = {1.0f, 0.5623413324356079f, 0.3162277638912201f, 0.17782793939113617f, 0.10000000149011612f, 0.05623413249850273f, 0.03162277489900589f, 0.017782794311642647f,
                                    0.009999999776482582f, 0.005623413249850273f, 0.003162277629598975f, 0.0017782794311642647f, 0.0010000000474974513f, 0.000562341301701963f, 0.0003162277571391314f, 0.00017782794020604342f};
        const float invf = INVF[j];
        const float ang = (float)pos * invf;
        const double t = (double)ang * 0.15915494309189533577;
        const float fr = (float)(t - __builtin_floor(t));
        ((GAS float*)(ws + WS_COS))[i] = __builtin_amdgcn_cosf(fr); ((GAS float*)(ws + WS_SIN))[i] = __builtin_amdgcn_sinf(fr);
    }
    for (int i = gt; i < M * PLE / 8; i += NGT) {
        const f32x4 a = *(const GAS f32x4*)(P.p + (size_t)i * 8), b = *(const GAS f32x4*)(P.p + (size_t)i * 8 + 4);
        v4u o; o.x = pk2(a[0], a[1]); o.y = pk2(a[2], a[3]); o.z = pk2(b[0], b[1]); o.w = pk2(b[2], b[3]);
        *(GAS v4u*)(ws + WS_PB + (size_t)i * 16) = o;
    }
    for (int m = gw; m < M; m += NGW) {
        const GAS f32x4* xr = (const GAS f32x4*)(P.x + (size_t)m * DM) + F.lane;
        f32x4 v[4]; float s = 0.f;
#pragma unroll
        for (int j = 0; j < 4; ++j) { v[j] = xr[64 * j]; s += (v[j].x * v[j].x + v[j].y * v[j].y) + (v[j].z * v[j].z + v[j].w * v[j].w); }
        const float rstd = rsqrtf(wave_sum(s) * (1.f / DM) + EPS);
        GAS unsigned long long* o8 = (GAS unsigned long long*)(ws + WS_HB + (size_t)m * DM * 2) + F.lane;
#pragma unroll
        for (int j = 0; j < 4; ++j) o8[64 * j] = (unsigned long long)pk2(v[j].x * rstd, v[j].y * rstd) | ((unsigned long long)pk2(v[j].z * rstd, v[j].w * rstd) << 32);
    }
}

__device__ __forceinline__ float bf_lo(unsigned w) { return __uint_as_float(w << 16); }
__device__ __forceinline__ float bf_hi(unsigned w) { return __uint_as_float(w & 0xffff0000u); }

__device__ __forceinline__ void p2_mixer_prep(Frame& F, const Ptrs& P) {
    unsigned char* ws = P.ws;
    const int gw = F.vcu * NWAVES + F.wave, NGW = F.G * NWAVES, lane = F.lane;
    const bf16* Z = (const bf16*)(ws + WS_Z);
    float cw0[8], cw1[8], cw2[8];
#pragma unroll
    for (int j = 0; j < 8; ++j) { cw0[j] = P.conv_w[8 * lane + j]; cw1[j] = P.conv_w[CONVW + 8 * lane + j]; cw2[j] = P.conv_w[2 * CONVW + 8 * lane + j]; }
    const float* cosT = (const float*)(ws + WS_COS); const float* sinT = (const float*)(ws + WS_SIN);
    for (int m = gw; m < M; m += NGW) {
        const int t = m & (SEQ - 1);
        const bf16* zr = Z + (size_t)m * DINP;
        const v4u zero4 = {0u, 0u, 0u, 0u};
        const v4u xc1 = *(const GAS v4u*)(zr + 8 * lane), cg1 = *(const GAS v4u*)(zr + 1024 + 8 * lane), bgv = *(const GAS v4u*)(zr + 512 + 8 * lane);
        const v4u xc0 = (t > 0) ? *(const GAS v4u*)(zr - DINP + 8 * lane) : zero4, cg0 = (t > 0) ? *(const GAS v4u*)(zr - DINP + 1024 + 8 * lane) : zero4;
        const v4u xc2 = (t < SEQ - 1) ? *(const GAS v4u*)(zr + DINP + 8 * lane) : zero4, cg2 = (t < SEQ - 1) ? *(const GAS v4u*)(zr + DINP + 1024 + 8 * lane) : zero4;
        v4u yo;
#pragma unroll
        for (int q = 0; q < 4; ++q) {
            const float u0l = bf_lo(xc0[q]) * bf_lo(cg0[q]), u0h = bf_hi(xc0[q]) * bf_hi(cg0[q]);
            const float u1l = bf_lo(xc1[q]) * bf_lo(cg1[q]), u1h = bf_hi(xc1[q]) * bf_hi(cg1[q]);
            const float u2l = bf_lo(xc2[q]) * bf_lo(cg2[q]), u2h = bf_hi(xc2[q]) * bf_hi(cg2[q]);
            const float yl = bf_lo(bgv[q]) * (cw0[2 * q] * u0l + cw1[2 * q] * u1l + cw2[2 * q] * u2l);
            const float yh = bf_hi(bgv[q]) * (cw0[2 * q + 1] * u0h + cw1[2 * q + 1] * u1h + cw2[2 * q + 1] * u2h);
            yo[q] = pk2(yl, yh);
        }
        *(GAS v4u*)(ws + WS_HB + ((size_t)m * DM + 8 * lane) * 2) = yo;
        { const unsigned long long w = *(const GAS unsigned long long*)(zr + 1536 + 4 * lane);
          const float a = bf_lo((unsigned)w), b = bf_hi((unsigned)w), c = bf_lo((unsigned)(w >> 32)), d = bf_hi((unsigned)(w >> 32));
          const float rs = rsqrtf(wave_sum((a * a + b * b) + (c * c + d * d)) * (1.f / QLORA) + EPS);
          *(GAS unsigned long long*)(ws + WS_QN + ((size_t)m * 256 + 4 * lane) * 2) = (unsigned long long)pk2(a * rs, b * rs) | ((unsigned long long)pk2(c * rs, d * rs) << 32); }
        { const unsigned w = *(const GAS unsigned*)(zr + 1792 + 2 * lane);
          const float a = bf_lo(w), b = bf_hi(w);
          const float rs = rsqrtf(wave_sum(a * a + b * b) * (1.f / KVLORA) + EPS);
          *(GAS unsigned*)(ws + WS_KVN + ((size_t)m * 256 + 2 * lane) * 2) = pk2(a * rs, b * rs);
          *(GAS unsigned*)(ws + WS_KVN + ((size_t)m * 256 + 128 + 2 * lane) * 2) = 0u; }
        { const int l = lane & 31, i = l & 15;
          const float xv = __uint_as_float((unsigned)zr[1920 + l] << 16);
          const float pv = __shfl_xor(xv, 16);
          const float c = cosT[t * 16 + i], s = sinT[t * 16 + i];
          const float o = (l < 16) ? (xv * c - pv * s) : (xv * c + pv * s);
          const bf16 ob = (bf16)f2bf(o);
          if (lane < 32) {
#pragma unroll
              for (int h = 0; h < NH; ++h) ((GAS bf16*)(ws + WS_K))[(size_t)m * LDKK + h * QKD + NOPE + l] = ob; }
        }
    }
}

__device__ __forceinline__ void p9_final_norm(Frame& F, const Ptrs& P) {
    const int gw = F.vcu * NWAVES + F.wave, NGW = F.G * NWAVES;
    const float* ssq = (const float*)(P.ws + WS_SSQ3);
    f32x4 g[4];
#pragma unroll
    for (int j = 0; j < 4; ++j) g[j] = ((const GAS f32x4*)P.g_final)[F.lane + 64 * j];
    for (int m = gw; m < M; m += NGW) {
        const float rs = pg8::rstd16(ssq, m);
        GAS f32x4* xr = (GAS f32x4*)(P.out + (size_t)m * DM) + F.lane;
#pragma unroll
        for (int j = 0; j < 4; ++j) { const f32x4 v = xr[64 * j]; xr[64 * j] = v * rs * g[j]; }
    }
}

struct Args { const float* in[19]; float* out; unsigned char* ws; int ph_lo, ph_hi; };
__global__ void __launch_bounds__(NWAVES * 64, 2) mk_fwd(Args args) {
    extern __shared__ __attribute__((aligned(16))) unsigned char lds[];
    Frame F;
    F.lds = (LAS unsigned char*)lds;
    F.tid = threadIdx.x; F.lane = F.tid & 63; F.wave = __builtin_amdgcn_readfirstlane(F.tid >> 6);
    F.G = gridDim.x; { const int bx = blockIdx.x; F.vcu = (F.G % 8 == 0) ? (bx % 8) * (F.G / 8) + bx / 8 : bx; }
    Ptrs P;
    P.x = args.in[0]; P.p = args.in[1]; P.g_mix = args.in[2]; P.w_in = args.in[3]; P.conv_w = args.in[4]; P.g_q = args.in[5]; P.w_uq = args.in[6]; P.g_kv = args.in[7];
    P.w_ukv = args.in[8]; P.w_o = args.in[9]; P.g_ffn = args.in[10]; P.w_up = args.in[11]; P.fcw = args.in[12]; P.fcb = args.in[13]; P.w_down = args.in[14];
    P.g_ple = args.in[15]; P.w_gate = args.in[16]; P.w_proj = args.in[17]; P.g_final = args.in[18]; P.out = args.out; P.ws = args.ws;
    unsigned char* ws = args.ws;
    volatile LAS unsigned* MISC = (volatile LAS unsigned*)(F.lds + MISC_OFF);
    if (F.tid < 128) MISC[F.tid] = 0u;
    __syncthreads();
    XcdBarrier bar; bar.bar = (unsigned*)(ws + WS_CTL) + CW_BAR; bar.x = 0; bar.st = nullptr;
    if (N_LAUNCHES == 1) bar = xcd_barrier_post((unsigned*)(ws + WS_CTL) + CW_BAR, MISC + 8);
    const int lo = args.ph_lo, hi = args.ph_hi;
#ifndef PHMASK
#define PHMASK 0x3ff
#endif
#define IN(k) (((PHMASK >> (k)) & 1) && lo <= (k) && (k) < hi)
#define SEAM(k) do { if (IN(k) && IN((k) + 1)) xcd_barrier(bar); } while (0)

    if (IN(0)) { p0_prologue(F, P); } SEAM(0);

    if (IN(1)) {
        pg8::Gemm g{(const pg8::bf16_t*)(ws + WS_HB), (const pg8::bf16_t*)(ws + WS_W1), M, DINP, DM}; pg8::StaticOrder S; S.init(M, DINP, F.G, (int)blockIdx.x);
        pg8::EpiStoreBf16 E{(pg8::bf16_t*)(ws + WS_Z), DINP};
        pg8::gemm_phase<pg8::EpiStoreBf16, pg8::StaticOrder, true, true>(F.lds + RING_OFF, g, S, E);
    } SEAM(1);

    if (IN(2)) { p2_mixer_prep(F, P); } SEAM(2);

    if (IN(3)) {
#ifndef P3MASK
#define P3MASK 7
#endif
        if (P3MASK & 1) { pg8::Gemm g{(const pg8::bf16_t*)(ws + WS_QN), (const pg8::bf16_t*)(ws + WS_WUQ), M, 768, 256}; pg8::StaticOrder S; S.init(M, 768, F.G, (int)blockIdx.x);
          pg8::EpiQ E{(pg8::bf16_t*)(ws + WS_Q), (const float*)(ws + WS_COS), (const float*)(ws + WS_SIN), QSCALE};
          pg8::gemm_phase<pg8::EpiQ, pg8::StaticOrder, true, true>(F.lds + RING_OFF, g, S, E); }
        if (P3MASK & 2) { pg8::Gemm g{(const pg8::bf16_t*)(ws + WS_KVN), (const pg8::bf16_t*)(ws + WS_WUKV), M, 1024, 256}; pg8::StaticOrder S; S.init(M, 1024, F.G, (int)blockIdx.x);
          pg8::EpiKV E{(pg8::bf16_t*)(ws + WS_K), (pg8::bf16_t*)(ws + WS_V)};
          pg8::gemm_phase<pg8::EpiKV, pg8::StaticOrder, true, true>(F.lds + RING_OFF, g, S, E); }
        if (P3MASK & 4) { pg8::Gemm g{(const pg8::bf16_t*)(ws + WS_PB), (const pg8::bf16_t*)(ws + WS_WPJ), M, 1024, 256}; pg8::StaticOrder S; S.init(M, 1024, F.G, (int)blockIdx.x);
          pg8::EpiStoreBf16 E{(pg8::bf16_t*)(ws + WS_PP), 1024};
          pg8::gemm_phase<pg8::EpiStoreBf16, pg8::StaticOrder, true, true>(F.lds + RING_OFF, g, S, E); }
    } SEAM(3);

    if (IN(4)) {
        static_assert(attn::LDS_BYTES <= RING_BYTES, "attention LDS");
        const int nunits = BATCH * NH * (SEQ / 256);
        for (int i = 0; ; ++i) {
            const int uidx = (F.G == 256) ? (((F.vcu >> 5) * 2 + i) * 32 + (F.vcu & 31)) : (i * F.G + F.vcu);
            if ((F.G == 256 && i >= 2) || uidx >= nunits) break;
            const int pair = uidx >> 5, qb = uidx & 31, b = pair >> 3, h = pair & 7;
            const size_t row0 = (size_t)b * SEQ;
            attn::attn_unit((const attn::bf16_t*)(ws + WS_Q) + (row0 + qb * 256) * LDQ + h * QKD, (const attn::bf16_t*)(ws + WS_K) + row0 * LDKK + h * QKD,
                            (const attn::bf16_t*)(ws + WS_V) + row0 * LDV + h * VH, (attn::bf16_t*)(ws + WS_HB) + (row0 + qb * 256) * DM + CONVW + h * VH, SEQ, (char*)lds + RING_OFF);
        }
    } SEAM(4);

    if (IN(5)) {
        pg8::Gemm g{(const pg8::bf16_t*)(ws + WS_HB), (const pg8::bf16_t*)(ws + WS_WO), M, DM, DM}; pg8::StaticOrder S; S.init(M, DM, F.G, (int)blockIdx.x);
        pg8::EpiRes E{P.x, P.out, (pg8::bf16_t*)(ws + WS_XB), (float*)(ws + WS_SSQ1)};
        pg8::gemm_phase<pg8::EpiRes, pg8::StaticOrder, true, true>(F.lds + RING_OFF, g, S, E);
    } SEAM(5);

    if (IN(6)) {
        pg8::Gemm g{(const pg8::bf16_t*)(ws + WS_XB), (const pg8::bf16_t*)(ws + WS_WUP), M, NUP, DM}; pg8::UpOrder S; S.init_up(F.G, (int)blockIdx.x);
        PG8_LAS float* rstd_l = (PG8_LAS float*)(F.lds + RSTD_OFF);
        { pg8::Unit u;
          for (int i = F.tid >> 8; i < 6 && S.next(i, u); i += 2) rstd_l[i * 256 + (F.tid & 255)] = pg8::rstd16((const float*)(ws + WS_SSQ1), u.arow + (F.tid & 255));
          __syncthreads(); }
        pg8::EpiUp E{(pg8::bf16_t*)(ws + WS_Z), P.fcw, P.fcb, (PG8_LAS float*)(F.lds + HALO_OFF), rstd_l};
        pg8::gemm_phase<pg8::EpiUp, pg8::UpOrder, true, true>(F.lds + RING_OFF, g, S, E);
    } SEAM(6);

    if (IN(7)) {
        pg8::Gemm g{(const pg8::bf16_t*)(ws + WS_Z), (const pg8::bf16_t*)(ws + WS_WDN), M, DM, DFF}; pg8::StaticOrder S; S.init(M, DM, F.G, (int)blockIdx.x);
        pg8::EpiRes E{P.out, P.out, (pg8::bf16_t*)(ws + WS_XB), (float*)(ws + WS_SSQ2)};
        pg8::gemm_phase<pg8::EpiRes, pg8::StaticOrder, true, true>(F.lds + RING_OFF, g, S, E);
    } SEAM(7);

    if (IN(8)) {
        pg8::Gemm g{(const pg8::bf16_t*)(ws + WS_XB), (const pg8::bf16_t*)(ws + WS_WG), M, DM, DM}; pg8::StaticOrder S; S.init(M, DM, F.G, (int)blockIdx.x);
        pg8::EpiGate E{P.out, P.out, (const pg8::bf16_t*)(ws + WS_PP), (const float*)(ws + WS_SSQ2), (float*)(ws + WS_SSQ3)};
        pg8::gemm_phase<pg8::EpiGate, pg8::StaticOrder, true, true>(F.lds + RING_OFF, g, S, E);
    } SEAM(8);

    if (IN(9)) { p9_final_norm(F, P); }
#undef IN
#undef SEAM
}

extern "C" void kernel_launch(void* const* d_in, const int* in_sizes, int n_in, void* d_out, int out_size, void* d_ws, size_t ws_size, hipStream_t stream) {
    static int grid = 0;
    if (grid == 0) {
        if (n_in != 19 || in_sizes[0] != M * DM || out_size != M * DM || ws_size < WS_END) { fprintf(stderr, "kernel_launch: unexpected shapes (n_in %d, in0 %d, out %d, ws %zu)\n", n_in, n_in > 0 ? in_sizes[0] : -1, out_size, ws_size); grid = -1; return; }
        int dev = 0, cus = 0, per_cu = 0;
        if (hipGetDevice(&dev) != hipSuccess || hipDeviceGetAttribute(&cus, hipDeviceAttributeMultiprocessorCount, dev) != hipSuccess) { grid = -1; return; }
        if (hipFuncSetAttribute((const void*)mk_fwd, hipFuncAttributeMaxDynamicSharedMemorySize, LDS_BYTES) != hipSuccess) { fprintf(stderr, "kernel_launch: hipFuncSetAttribute failed\n"); grid = -1; return; }
        if (hipOccupancyMaxActiveBlocksPerMultiprocessor(&per_cu, (const void*)mk_fwd, NWAVES * 64, LDS_BYTES) != hipSuccess || per_cu < 1) { fprintf(stderr, "kernel_launch: occupancy query says %d blocks per CU\n", per_cu); per_cu = 1; }
        (void)hipGetLastError();
        grid = cus;
    }
    if (grid < 0) return;
    if (hipMemsetAsync((char*)d_ws + WS_CTL, 0, CTL_ZERO_BYTES, stream) != hipSuccess) { fprintf(stderr, "kernel_launch: memset failed\n"); return; }
    Args a{};
    for (int i = 0; i < 19; ++i) a.in[i] = (const float*)d_in[i];
    a.out = (float*)d_out; a.ws = (unsigned char*)d_ws;
    if (N_LAUNCHES == 1) {
        a.ph_lo = 0; a.ph_hi = N_PHASES;
        void* kargs[] = {&a};
        hipError_t e = hipLaunchCooperativeKernel((const void*)mk_fwd, dim3(grid), dim3(NWAVES * 64), kargs, LDS_BYTES, stream);
        if (e != hipSuccess) fprintf(stderr, "kernel_launch: cooperative launch failed: %s (grid %d)\n", hipGetErrorString(e), grid);
    } else {
        for (int li = 0; li < N_PHASES; ++li) {
            a.ph_lo = li; a.ph_hi = li + 1;
            hipLaunchKernelGGL(mk_fwd, dim3(grid), dim3(NWAVES * 64), LDS_BYTES, stream, a);
        }
        const hipError_t le = hipPeekAtLastError();
        if (le != hipSuccess) fprintf(stderr, "kernel_launch: launch failed: %s\n", hipGetErrorName(le));
    }
}
```

```cpp
#include <hip/hip_runtime.h>
#include <hip/hip_bf16.h>
#include <cstdio>
#include <cstdint>
#include <cmath>

constexpr int BATCH = 2, SEQ = 8192, DM = 1024, M = BATCH * SEQ;
constexpr int PLE = 256, CONVW = 512, NH = 8, QLORA = 256, KVLORA = 128, NOPE = 64, ROPE = 32, VH = 64, QKD = 96;
constexpr int DIN = 1952, DINP = 2048, DFF = 2816, NUP = 2 * DFF;
constexpr int LDQ = NH * QKD, LDKK = NH * QKD, LDV = NH * VH;
constexpr float EPS = 1e-6f;
constexpr float QSCALE = 0.10206207261596575f * 1.4426950408889634f;
namespace pg8 {
#define PG8_LAS __attribute__((address_space(3)))
typedef unsigned short bf16_t;
typedef short bf16x8 __attribute__((ext_vector_type(8)));
typedef float f32x4 __attribute__((ext_vector_type(4)));
typedef unsigned u32x4 __attribute__((ext_vector_type(4)));
constexpr int BM = 256, BK = 64, HALF = 128, HTB = HALF * BK * 2  , STAGE_BYTES = 8 * HTB, NXCD = 8, WGM = 8;

__host__ __device__ __forceinline__ int lds_byte(int r, int c) { const int st = (r >> 4) * 2 + (c >> 5), rr = r & 15, cc = c & 31, ob = rr * 64 + cc * 2; return st * 1024 + (ob ^ (((ob >> 9) & 1) << 5)); }
__host__ __device__ __forceinline__ void stage_rc(int b, int& R, int& C) { const int st = b / 1024, sb = b % 1024, swz = sb ^ (((sb >> 9) & 1) << 5); R = (st >> 1) * 16 + swz / 64; C = (st & 1) * 32 + (swz % 64) / 2; }
__host__ __device__ __forceinline__ int perm32(int rho) { const int n = rho >> 4, i = rho & 15; return 8 * (i >> 2) + 4 * n + (i & 3); }

struct Unit { int pm, pn, arow, ord; };
struct Gemm { const bf16_t* A; const bf16_t* Bt; int M, N, K; };

struct StaticOrder {
    int nM, nN, nwg, G, c;
    __host__ __device__ void init(int M, int N, int G_, int c_) { nM = M / BM; nN = N / BM; nwg = nM * nN; G = G_; c = c_; }
    __host__ __device__ bool next(int i, Unit& u) const {
        const long L = (long)i * G + c; if (L >= nwg) return false;
        int wgid = (int)L; { const int q = nwg / NXCD, r = nwg % NXCD, xcd = wgid % NXCD, off = wgid / NXCD; wgid = (xcd < r ? xcd * (q + 1) : r * (q + 1) + (xcd - r) * q) + off; }
        const int nig = WGM * nN, gid = wgid / nig, fm = gid * WGM, gsz = (nM - fm) < WGM ? (nM - fm) : WGM;
        u.pm = fm + ((wgid % nig) % gsz); u.pn = (wgid % nig) / gsz; u.arow = u.pm * BM; u.ord = i; return true;
    }
    __device__ __forceinline__ void a_ready(const Unit&) const {}
    __device__ __forceinline__ void done(const Unit&) const {}
};

__device__ __forceinline__ unsigned cvt_pk_bf16(float lo, float hi) { unsigned r; asm volatile("v_cvt_pk_bf16_f32 %0, %1, %2" : "=v"(r) : "v"(lo), "v"(hi)); return r; }
typedef float f32x2 __attribute__((ext_vector_type(2)));
typedef unsigned u32x2 __attribute__((ext_vector_type(2)));
__device__ __forceinline__ u32x2 pack4(const f32x4 v) { u32x2 w; w.x = cvt_pk_bf16(v[0], v[1]); w.y = cvt_pk_bf16(v[2], v[3]); return w; }
__device__ __forceinline__ u32x4 pack8(const f32x4 a, const f32x4 b) { u32x4 w; w.x = cvt_pk_bf16(a[0], a[1]); w.y = cvt_pk_bf16(a[2], a[3]); w.z = cvt_pk_bf16(b[0], b[1]); w.w = cvt_pk_bf16(b[2], b[3]); return w; }
__device__ __forceinline__ f32x4 unpack4(const u32x2 w) { f32x4 v; v[0] = __uint_as_float(w.x << 16); v[1] = __uint_as_float(w.x & 0xffff0000u); v[2] = __uint_as_float(w.y << 16); v[3] = __uint_as_float(w.y & 0xffff0000u); return v; }
__device__ __forceinline__ float rstd16(const float* ssqp, int row) {
    const f32x4* p = (const f32x4*)(ssqp + (size_t)row * 16); const f32x4 a = p[0], b = p[1], c = p[2], d = p[3];
    const float s = ((a[0] + a[1]) + (a[2] + a[3])) + ((b[0] + b[1]) + (b[2] + b[3])) + ((c[0] + c[1]) + (c[2] + c[3])) + ((d[0] + d[1]) + (d[2] + d[3]));
    return rsqrtf(s * (1.0f / 1024.0f) + 1e-6f);
}


struct EpiStoreBf16 {
    static constexpr bool PERM = true, AFTER_DRAIN = false;
    bf16_t* O; int ldc;
    __device__ __forceinline__ void operator()(f32x4 (&acc)[2][2][4][2], const Unit& u, int wr, int wc, int fr, int fq, int lane) const {
        const int row0 = u.pm * BM + wr * 64 + fr, col0 = u.pn * BM + wc * 32 + 8 * fq;
#pragma unroll
        for (int ai = 0; ai < 2; ++ai)
#pragma unroll
            for (int m = 0; m < 4; ++m) { bf16_t* rowp = O + (size_t)(row0 + ai * HALF + m * 16) * ldc + col0;
#pragma unroll
                for (int bj = 0; bj < 2; ++bj) *(u32x4*)(rowp + bj * HALF) = pack8(acc[ai][bj][m][0], acc[ai][bj][m][1]); }
    }
};

struct EpiQ {
    static constexpr bool PERM = false, AFTER_DRAIN = false;
    bf16_t* Q; const float* cosT; const float* sinT; float scale;
    __device__ __forceinline__ void operator()(f32x4 (&acc)[2][2][4][2], const Unit& u, int wr, int wc, int fr, int fq, int lane) const {
        const int row0 = u.pm * BM + wr * 64 + fr;
#pragma unroll
        for (int bj = 0; bj < 2; ++bj) {
            const int gc0 = u.pn * BM + bj * HALF + wc * 32;
            const bool rope = (gc0 % 96) == 64;
#pragma unroll
            for (int ai = 0; ai < 2; ++ai)
#pragma unroll
                for (int m = 0; m < 4; ++m) {
                    const int row = row0 + ai * HALF + m * 16, pos = row & (SEQ - 1);
                    f32x4 v0 = acc[ai][bj][m][0], v1 = acc[ai][bj][m][1];
                    if (rope) { const f32x4 c = *(const f32x4*)(cosT + pos * 16 + 4 * fq), s = *(const f32x4*)(sinT + pos * 16 + 4 * fq);
                        const f32x4 o0 = v0 * c - v1 * s, o1 = v1 * c + v0 * s; v0 = o0; v1 = o1; }
                    v0 = v0 * scale; v1 = v1 * scale;
                    bf16_t* p = Q + (size_t)row * 768 + gc0 + 4 * fq;
                    *(u32x2*)p = pack4(v0); *(u32x2*)(p + 16) = pack4(v1);
                    asm volatile("" ::: "memory");
                }
        }
    }
};

struct EpiKV {
    static constexpr bool PERM = true, AFTER_DRAIN = false;
    bf16_t* Kb; bf16_t* Vb;
    __device__ __forceinline__ void operator()(f32x4 (&acc)[2][2][4][2], const Unit& u, int wr, int wc, int fr, int fq, int lane) const {
        const int row0 = u.pm * BM + wr * 64 + fr;
#pragma unroll
        for (int bj = 0; bj < 2; ++bj) {
            const int head = 2 * u.pn + bj, within = wc * 32 + 8 * fq;
            bf16_t* base = (wc < 2) ? (Kb + head * 96 + within) : (Vb + head * 64 + (within - 64));
            const int ld = (wc < 2) ? 768 : 512;
#pragma unroll
            for (int ai = 0; ai < 2; ++ai)
#pragma unroll
                for (int m = 0; m < 4; ++m) { const int row = row0 + ai * HALF + m * 16;
                    *(u32x4*)(base + (size_t)row * ld) = pack8(acc[ai][bj][m][0], acc[ai][bj][m][1]); }
        }
    }
};

template <bool RESB> struct EpiRes {
    static constexpr bool PERM = false, AFTER_DRAIN = false;
    const float* resf; const bf16_t* resb; bf16_t* xb; float* ssqp;
    __device__ __forceinline__ void operator()(f32x4 (&acc)[2][2][4][2], const Unit& u, int wr, int wc, int fr, int fq, int lane) const {
        const int col0 = u.pn * BM + wc * 32 + 4 * fq;
#pragma unroll
        for (int ai = 0; ai < 2; ++ai)
#pragma unroll
            for (int m = 0; m < 4; ++m) {
                const int row = u.pm * BM + ai * HALF + wr * 64 + m * 16 + fr; const size_t off = (size_t)row * 1024 + col0; float ss = 0.f;
#pragma unroll
                for (int bj = 0; bj < 2; ++bj)
#pragma unroll
                    for (int n = 0; n < 2; ++n) { const size_t o = off + bj * HALF + n * 16;
                        const f32x4 r = RESB ? unpack4(*(const u32x2*)(resb + o)) : *(const f32x4*)(resf + o); const f32x4 v = r + acc[ai][bj][m][n];
                        *(u32x2*)(xb + o) = pack4(v); ss += (v[0] * v[0] + v[1] * v[1]) + (v[2] * v[2] + v[3] * v[3]); }
                ss += __shfl_xor(ss, 16); ss += __shfl_xor(ss, 32);
                if (fq == 0) ssqp[(size_t)row * 16 + u.pn * 4 + wc] = ss;
                asm volatile("" ::: "memory");
            }
    }
};

struct EpiGate {
    static constexpr bool PERM = false, AFTER_DRAIN = false;
    const bf16_t* x2; bf16_t* out; const bf16_t* pp; const float* ssq2p; float* ssq3p;
    __device__ __forceinline__ void operator()(f32x4 (&acc)[2][2][4][2], const Unit& u, int wr, int wc, int fr, int fq, int lane) const {
        const int col0 = u.pn * BM + wc * 32 + 4 * fq;
#pragma unroll
        for (int ai = 0; ai < 2; ++ai)
#pragma unroll
            for (int m = 0; m < 4; ++m) {
                const int row = u.pm * BM + ai * HALF + wr * 64 + m * 16 + fr; const size_t off = (size_t)row * 1024 + col0; float ss = 0.f;
                const float rs = rstd16(ssq2p, row);
#pragma unroll
                for (int bj = 0; bj < 2; ++bj)
#pragma unroll
                    for (int n = 0; n < 2; ++n) { const size_t o = off + bj * HALF + n * 16; const f32x4 a = acc[ai][bj][m][n] * rs; f32x4 g;
#pragma unroll
                        for (int j = 0; j < 4; ++j) g[j] = __builtin_amdgcn_rcpf(1.0f + __expf(-a[j]));
                        const f32x4 v = unpack4(*(const u32x2*)(x2 + o)) + g * unpack4(*(const u32x2*)(pp + o));
                        *(u32x2*)(out + o) = pack4(v); ss += (v[0] * v[0] + v[1] * v[1]) + (v[2] * v[2] + v[3] * v[3]); }
                ss += __shfl_xor(ss, 16); ss += __shfl_xor(ss, 32);
                if (fq == 0) ssq3p[(size_t)row * 16 + u.pn * 4 + wc] = ss;
                asm volatile("" ::: "memory");
            }
    }
};

__device__ __forceinline__ float dpp_ror1(float v) { return __builtin_bit_cast(float, __builtin_amdgcn_update_dpp(0, __builtin_bit_cast(int, v), 0x121, 0xf, 0xf, false)); }
__device__ __forceinline__ float dpp_ror15(float v) { return __builtin_bit_cast(float, __builtin_amdgcn_update_dpp(0, __builtin_bit_cast(int, v), 0x12F, 0xf, 0xf, false)); }
__device__ __forceinline__ f32x4 ror1v(const f32x4 v) { f32x4 r; r[0] = dpp_ror1(v[0]); r[1] = dpp_ror1(v[1]); r[2] = dpp_ror1(v[2]); r[3] = dpp_ror1(v[3]); return r; }
__device__ __forceinline__ f32x4 ror15v(const f32x4 v) { f32x4 r; r[0] = dpp_ror15(v[0]); r[1] = dpp_ror15(v[1]); r[2] = dpp_ror15(v[2]); r[3] = dpp_ror15(v[3]); return r; }
struct EpiUp {
    static constexpr bool PERM = true, AFTER_DRAIN = false;
    bf16_t* H; const float* cw; const float* cb; PG8_LAS float* halo; const PG8_LAS float* rstd;
    __device__ __forceinline__ void operator()(f32x4 (&acc)[2][2][4][2], const Unit& u, int wr, int wc, int fr, int fq, int lane) const {
        const int s = u.arow & (SEQ - 1); const bool first = (s == 0), last = (s + 256 == SEQ);
        const int ch0 = wc * 32 + 8 * fq;
#pragma unroll
        for (int ai = 0; ai < 2; ++ai)
#pragma unroll
            for (int m = 0; m < 4; ++m) { const float rs = rstd[u.ord * 256 + ai * HALF + wr * 64 + m * 16 + fr];
#pragma unroll
                for (int bj = 0; bj < 2; ++bj)
#pragma unroll
                    for (int n = 0; n < 2; ++n) acc[ai][bj][m][n] = acc[ai][bj][m][n] * rs; }
#pragma unroll
        for (int ai = 0; ai < 2; ++ai) { const int seg = 2 * ai + wr;
            if (fr == 0) {
#pragma unroll
                for (int bj = 0; bj < 2; ++bj)
#pragma unroll
                    for (int n = 0; n < 2; ++n) *(PG8_LAS f32x4*)(halo + (seg * 2 + 0) * 256 + bj * HALF + ch0 + 4 * n) = acc[ai][bj][0][n]; }
            if (fr == 15) {
#pragma unroll
                for (int bj = 0; bj < 2; ++bj)
#pragma unroll
                    for (int n = 0; n < 2; ++n) *(PG8_LAS f32x4*)(halo + (seg * 2 + 1) * 256 + bj * HALF + ch0 + 4 * n) = acc[ai][bj][3][n]; }
        }
        asm volatile("s_waitcnt lgkmcnt(0)" ::: "memory"); __builtin_amdgcn_s_barrier(); asm volatile("" ::: "memory");
        const f32x4 z4 = {0.f, 0.f, 0.f, 0.f};
#pragma unroll
        for (int n = 0; n < 2; ++n) {
            const int gch = u.pn * 128 + ch0 + 4 * n;
            const f32x4 wg0 = *(const f32x4*)(cw + gch), wg1 = *(const f32x4*)(cw + NUP + gch), wg2 = *(const f32x4*)(cw + 2 * NUP + gch), bg = *(const f32x4*)(cb + gch);
            const f32x4 wu0 = *(const f32x4*)(cw + DFF + gch), wu1 = *(const f32x4*)(cw + NUP + DFF + gch), wu2 = *(const f32x4*)(cw + 2 * NUP + DFF + gch), bu = *(const f32x4*)(cb + DFF + gch);
#pragma unroll
            for (int ai = 0; ai < 2; ++ai) {
                const int seg = 2 * ai + wr, sup = seg > 0 ? seg - 1 : 0, sdn = seg < 3 ? seg + 1 : 3;
#pragma unroll
                for (int m = 0; m < 4; ++m) {
                    const int r = ai * HALF + wr * 64 + m * 16 + fr, t = s + r;
                    f32x4 pg, pu, ng, nu;
                    if (m == 0) { pg = *(const PG8_LAS f32x4*)(halo + (sup * 2 + 1) * 256 + ch0 + 4 * n); pu = *(const PG8_LAS f32x4*)(halo + (sup * 2 + 1) * 256 + HALF + ch0 + 4 * n); }
                    else { pg = acc[ai][0][m > 0 ? m - 1 : 0][n]; pu = acc[ai][1][m > 0 ? m - 1 : 0][n]; }
                    if (m == 3) { ng = *(const PG8_LAS f32x4*)(halo + (sdn * 2 + 0) * 256 + ch0 + 4 * n); nu = *(const PG8_LAS f32x4*)(halo + (sdn * 2 + 0) * 256 + HALF + ch0 + 4 * n); }
                    else { ng = acc[ai][0][m < 3 ? m + 1 : 3][n]; nu = acc[ai][1][m < 3 ? m + 1 : 3][n]; }
                    const f32x4 vg = acc[ai][0][m][n], vu = acc[ai][1][m][n];
                    f32x4 upg = ror1v(fr == 15 ? pg : vg), upu = ror1v(fr == 15 ? pu : vu), dng = ror15v(fr == 0 ? ng : vg), dnu = ror15v(fr == 0 ? nu : vu);
                    if (t == 0) { upg = z4; upu = z4; }
                    if (t == SEQ - 1) { dng = z4; dnu = z4; }
                    const f32x4 ag = wg0 * upg + wg1 * vg + wg2 * dng + bg, au = wu0 * upu + wu1 * vu + wu2 * dnu + bu;
                    f32x4 hv;
#pragma unroll
                    for (int j = 0; j < 4; ++j) hv[j] = ag[j] * __builtin_amdgcn_rcpf(1.0f + __expf(-ag[j])) * au[j];
                    if ((r > 0 || first) && (r < 255 || last)) *(u32x2*)(H + (size_t)(u.arow + r) * DFF + u.pn * 128 + ch0 + 4 * n) = pack4(hv);
                }
            }
        }
    }
};
struct UpOrder : StaticOrder {
    __host__ __device__ void init_up(int G_, int c_) { nM = 66; nN = 22; nwg = nM * nN; G = G_; c = c_; }
    __host__ __device__ bool next(int i, Unit& u) const {
        if (!StaticOrder::next(i, u)) return false;
        const int b = u.pm / 33, k = u.pm % 33; int st = 254 * k; if (st > SEQ - 256) st = SEQ - 256;
        u.arow = b * SEQ + st; u.ord = i; return true;
    }
};
template <class Base, int D> struct DupOrder : Base {
    __host__ __device__ bool next(int i, Unit& u) const { return Base::next(D ? (i >> 1) : i, u); }
};
template <class Epi, class Sched, bool ALIGN_EPI = false, bool SP2 = false>
__device__ __forceinline__ void gemm_phase(PG8_LAS unsigned char* lds, const Gemm g, const Sched& S, const Epi& E) {
    const int tid = threadIdx.x, wid = __builtin_amdgcn_readfirstlane(tid >> 6), lane = tid & 63, wr = wid >> 2, wc = wid & 3, fr = lane & 15, fq = lane >> 4;
    int K_ = g.K; asm volatile("" : "+s"(K_));
    const int K = K_, nt = K / BK;
    unsigned voffA[2], voffB[2];
#pragma unroll
    for (int i = 0; i < 2; ++i) { int R, C; stage_rc(tid * 16 + i * 8192, R, C); const int Rb = Epi::PERM ? ((R & ~31) + perm32(R & 31)) : R;
        voffA[i] = (unsigned)(R * K + C) * 2u; voffB[i] = (unsigned)(Rb * K + C) * 2u; }
    const size_t kstep = (size_t)(BK * 2);
    const size_t hstep = (size_t)HALF * K * 2;
    const size_t rstep = (size_t)K * 2;
    const size_t tstep = 2 * hstep;
    const unsigned ldsw = (unsigned)wid * 1024u;
    const int aoff = lds_byte(wr * 64 + fr, fq * 8), boff = lds_byte(wc * 32 + fr, fq * 8);
#define PG8_SA(b, h) (((b) * 2 + (h)) * HTB)
#define PG8_SB(b, h) ((4 + (b) * 2 + (h)) * HTB)
#define PG8_STAGE(bufoff, gbase, voff) do { _Pragma("unroll") for (int _i = 0; _i < 2; ++_i) \
        __builtin_amdgcn_global_load_lds((const unsigned*)((const char*)(gbase) + (voff)[_i]), (PG8_LAS unsigned*)(lds + (bufoff) + ldsw + _i * 8192), 16, 0, 0); } while (0)
#define PG8_LDA(dst, b, h) do { _Pragma("unroll") for (int m = 0; m < 4; ++m) _Pragma("unroll") for (int k = 0; k < 2; ++k) dst[m][k] = *(const PG8_LAS bf16x8*)(lds + PG8_SA(b, h) + aoff + m * 2048 + k * 1024); } while (0)
#define PG8_LDB(dst, b, h) do { _Pragma("unroll") for (int n = 0; n < 2; ++n) _Pragma("unroll") for (int k = 0; k < 2; ++k) dst[n][k] = *(const PG8_LAS bf16x8*)(lds + PG8_SB(b, h) + boff + n * 2048 + k * 1024); } while (0)
#define PG8_MMA(ai, bj, At, Bt) do { __builtin_amdgcn_s_setprio(1); _Pragma("unroll") for (int m = 0; m < 4; ++m) _Pragma("unroll") for (int n = 0; n < 2; ++n) _Pragma("unroll") for (int k = 0; k < 2; ++k) \
        acc[ai][bj][m][n] = __builtin_amdgcn_mfma_f32_16x16x32_bf16(Bt[n][k], At[m][k], acc[ai][bj][m][n], 0, 0, 0); __builtin_amdgcn_s_setprio(0); } while (0)
#define PG8_WAIT_V(n) asm volatile("s_waitcnt vmcnt(" #n ")" ::: "memory")
#define PG8_WAIT_L(n) asm volatile("s_waitcnt lgkmcnt(" #n ")" ::: "memory")
#define PG8_BAR __builtin_amdgcn_s_barrier()
#define PG8_SCHED __builtin_amdgcn_sched_barrier(0)
    Unit cur, nxt; int ui = 0;
    if (!S.next(0, cur)) return;
    f32x4 acc[2][2][4][2];
#pragma unroll
    for (int a = 0; a < 2; ++a)
#pragma unroll
        for (int b = 0; b < 2; ++b)
#pragma unroll
            for (int m = 0; m < 4; ++m)
#pragma unroll
                for (int n = 0; n < 2; ++n) acc[a][b][m][n] = (f32x4){0.f, 0.f, 0.f, 0.f};
    bf16x8 At[4][2], B0[2][2], B1[2][2];
    const char* cA = (const char*)g.A + (size_t)cur.arow * rstep; const char* cB = (const char*)g.Bt + (size_t)cur.pn * tstep;
    S.a_ready(cur);
    if constexpr (SP2) {
        PG8_STAGE(PG8_SB(0, 0), cB, voffB); PG8_STAGE(PG8_SB(0, 1), cB + hstep, voffB); PG8_STAGE(PG8_SA(0, 0), cA, voffA); PG8_STAGE(PG8_SA(0, 1), cA + hstep, voffA);
        if (wr == 1) PG8_BAR;
        PG8_WAIT_V(2); PG8_BAR;
        PG8_STAGE(PG8_SB(1, 0), cB + kstep, voffB); PG8_STAGE(PG8_SA(1, 0), cA + kstep, voffA); PG8_STAGE(PG8_SB(1, 1), cB + hstep + kstep, voffB);
        PG8_WAIT_V(6); PG8_BAR;
    } else {
        PG8_STAGE(PG8_SB(0, 0), cB, voffB); PG8_STAGE(PG8_SA(0, 0), cA, voffA); PG8_STAGE(PG8_SB(0, 1), cB + hstep, voffB); PG8_STAGE(PG8_SA(0, 1), cA + hstep, voffA);
        if (wr == 1) PG8_BAR;
        PG8_WAIT_V(4); PG8_BAR;
        PG8_STAGE(PG8_SB(1, 0), cB + kstep, voffB); PG8_STAGE(PG8_SA(1, 0), cA + kstep, voffA); PG8_STAGE(PG8_SB(1, 1), cB + hstep + kstep, voffB);
        PG8_WAIT_V(6); PG8_BAR;
    }
    for (;;) {
        const bool has_next = S.next(ui + 1, nxt);
        const char* nA = has_next ? (const char*)g.A + (size_t)nxt.arow * rstep : cA; const char* nB = has_next ? (const char*)g.Bt + (size_t)nxt.pn * tstep : cB;
        for (int t = 0; t < nt; t += 2) {
            const bool last = (t == nt - 2);
            const char* a1 = cA + (size_t)(t + 1) * kstep;
            const char* a2 = last ? nA : cA + (size_t)(t + 2) * kstep; const char* b2 = last ? nB : cB + (size_t)(t + 2) * kstep;
            const char* a3 = a2 + kstep; const char* b3 = b2 + kstep;
            if (last && has_next) S.a_ready(nxt);
            if constexpr (SP2) {
            PG8_LDB(B0, 0, 0); PG8_LDB(B1, 0, 1); PG8_SCHED; PG8_LDA(At, 0, 0); PG8_STAGE(PG8_SA(1, 1), a1 + hstep, voffA);
            PG8_WAIT_V(8); PG8_WAIT_L(0); PG8_BAR; PG8_MMA(0, 0, At, B0); PG8_MMA(0, 1, At, B1); PG8_BAR; PG8_SCHED;
            PG8_LDA(At, 0, 1); PG8_STAGE(PG8_SB(0, 0), b2, voffB); PG8_STAGE(PG8_SB(0, 1), b2 + hstep, voffB); PG8_STAGE(PG8_SA(0, 0), a2, voffA);
            PG8_WAIT_V(8); PG8_WAIT_L(0); PG8_BAR; PG8_MMA(1, 0, At, B0); PG8_MMA(1, 1, At, B1); PG8_BAR; PG8_SCHED;
            PG8_LDB(B0, 1, 0); PG8_LDB(B1, 1, 1); PG8_SCHED; PG8_LDA(At, 1, 0); PG8_STAGE(PG8_SA(0, 1), a2 + hstep, voffA);
            PG8_WAIT_V(8); PG8_WAIT_L(0); PG8_BAR; PG8_MMA(0, 0, At, B0); PG8_MMA(0, 1, At, B1); PG8_BAR; PG8_SCHED;
            PG8_LDA(At, 1, 1); PG8_STAGE(PG8_SB(1, 0), b3, voffB); PG8_STAGE(PG8_SB(1, 1), b3 + hstep, voffB); PG8_STAGE(PG8_SA(1, 0), a3, voffA);
            PG8_WAIT_V(8); PG8_WAIT_L(0); PG8_BAR; PG8_MMA(1, 0, At, B0); PG8_MMA(1, 1, At, B1); PG8_BAR; PG8_SCHED;
            } else {
            PG8_LDB(B0, 0, 0); PG8_SCHED; PG8_LDA(At, 0, 0); PG8_STAGE(PG8_SA(1, 1), a1 + hstep, voffA);
            PG8_WAIT_L(8); PG8_BAR; PG8_WAIT_L(0); PG8_MMA(0, 0, At, B0); PG8_BAR; PG8_SCHED;
            PG8_LDB(B1, 0, 1); PG8_STAGE(PG8_SB(0, 0), b2, voffB);
            PG8_BAR; PG8_WAIT_L(0); PG8_MMA(0, 1, At, B1); PG8_BAR;
            PG8_LDA(At, 0, 1); PG8_STAGE(PG8_SA(0, 0), a2, voffA);
            PG8_BAR; PG8_WAIT_L(0); PG8_MMA(1, 0, At, B0); PG8_BAR; PG8_SCHED;
            PG8_STAGE(PG8_SB(0, 1), b2 + hstep, voffB);
            PG8_WAIT_V(6); PG8_BAR; PG8_MMA(1, 1, At, B1); PG8_BAR;
            PG8_LDB(B0, 1, 0); PG8_SCHED; PG8_LDA(At, 1, 0); PG8_STAGE(PG8_SA(0, 1), a2 + hstep, voffA);
            PG8_WAIT_L(8); PG8_BAR; PG8_WAIT_L(0); PG8_MMA(0, 0, At, B0); PG8_BAR; PG8_SCHED;
            PG8_LDB(B1, 1, 1); PG8_STAGE(PG8_SB(1, 0), b3, voffB);
            PG8_BAR; PG8_WAIT_L(0); PG8_MMA(0, 1, At, B1); PG8_BAR;
            PG8_LDA(At, 1, 1); PG8_STAGE(PG8_SA(1, 0), a3, voffA);
            PG8_BAR; PG8_WAIT_L(0); PG8_MMA(1, 0, At, B0); PG8_BAR; PG8_SCHED;
            PG8_STAGE(PG8_SB(1, 1), b3 + hstep, voffB);
            PG8_WAIT_V(6); PG8_BAR; PG8_MMA(1, 1, At, B1); PG8_BAR;
            }
        }
        if constexpr (ALIGN_EPI) { if (wr == 0) PG8_BAR; }
        if constexpr (!Epi::AFTER_DRAIN) { E(acc, cur, wr, wc, fr, fq, lane); S.done(cur); }
        if (!has_next) break;
#pragma unroll
        for (int a = 0; a < 2; ++a)
#pragma unroll
            for (int b = 0; b < 2; ++b)
#pragma unroll
                for (int m = 0; m < 4; ++m)
#pragma unroll
                    for (int n = 0; n < 2; ++n) acc[a][b][m][n] = (f32x4){0.f, 0.f, 0.f, 0.f};
        cur = nxt; cA = nA; cB = nB; ++ui;
        if constexpr (ALIGN_EPI) { if (wr == 1) PG8_BAR; }
    }
    PG8_WAIT_V(0);
    if constexpr (!ALIGN_EPI) { if (wr == 0) PG8_BAR; }
    PG8_BAR;
    if constexpr (Epi::AFTER_DRAIN) { E.fused(acc, cur, wr, wc, fr, fq, lds, wid, lane); S.done(cur); }
#undef PG8_SA
#undef PG8_SB
#undef PG8_STAGE
#undef PG8_LDA
#undef PG8_LDB
#undef PG8_MMA
#undef PG8_WAIT_V
#undef PG8_WAIT_L
#undef PG8_BAR
#undef PG8_SCHED
}
}
namespace attn {
using bf16x8 = __attribute__((ext_vector_type(8))) short;
using s16x4  = __attribute__((ext_vector_type(4))) short;
using f32x16 = __attribute__((ext_vector_type(16))) float;
using u32x4  = __attribute__((ext_vector_type(4))) unsigned;
typedef unsigned short bf16_t;
constexpr int NW = 8, QBLK = 32, KVBLK = 64, KROW = 208;
constexpr int SHM_V = KVBLK * 64 * 2, SHM_K = KVBLK * KROW, LDS_WS = 2 * SHM_V + 2 * SHM_K, LDS_BYTES = LDS_WS + NW * 64 * 4;
constexpr float THR = 8.f;
#define ASBAR() __builtin_amdgcn_sched_barrier(0)
__device__ __forceinline__ int crow(int r, int hi) { return (r & 3) + 8 * (r >> 2) + 4 * hi; }
__device__ __forceinline__ unsigned cvtpk(float lo, float hi) { unsigned r; asm volatile("v_cvt_pk_bf16_f32 %0, %1, %2" : "=v"(r) : "v"(lo), "v"(hi)); return r; }

__device__ __forceinline__ void partialSM(f32x16& p0, f32x16& p1, float& m_reg, float& alpha) {
  float pmax = p0[0];
#pragma unroll
  for (int r = 1; r < 16; ++r) pmax = fmaxf(pmax, p0[r]);
#pragma unroll
  for (int r = 0; r < 16; ++r) pmax = fmaxf(pmax, p1[r]);
  { auto rr = __builtin_amdgcn_permlane32_swap(__float_as_uint(pmax), __float_as_uint(pmax), false, false);
    pmax = fmaxf(__uint_as_float(rr[0]), __uint_as_float(rr[1])); }
  float mn;
  if (__builtin_expect(__all(pmax - m_reg <= THR), 1)) { mn = m_reg; alpha = 1.f; }
  else { mn = fmaxf(m_reg, pmax); alpha = __builtin_amdgcn_exp2f(m_reg - mn); m_reg = mn; }
#pragma unroll
  for (int r = 0; r < 16; ++r) p0[r] = p0[r] - mn;
#pragma unroll
  for (int r = 0; r < 16; ++r) p1[r] = p1[r] - mn;
#pragma unroll
  for (int r = 0; r < 16; ++r) p0[r] = __builtin_amdgcn_exp2f(p0[r]);
}
__device__ __forceinline__ void finishSM(f32x16& p0, f32x16& p1, float alpha, float& l_reg, bf16x8& pa0, bf16x8& pa1, bf16x8& pa2, bf16x8& pa3) {
#pragma unroll
  for (int r = 0; r < 16; ++r) p1[r] = __builtin_amdgcn_exp2f(p1[r]);
  float ps = 0;
#pragma unroll
  for (int r = 0; r < 16; ++r) ps += p0[r];
#pragma unroll
  for (int r = 0; r < 16; ++r) ps += p1[r];
  { auto rr = __builtin_amdgcn_permlane32_swap(__float_as_uint(ps), __float_as_uint(ps), false, false);
    ps = __uint_as_float(rr[0]) + __uint_as_float(rr[1]); }
  l_reg = l_reg * alpha + ps;
#define PK4(P, BASE, OUT) do { unsigned a0 = cvtpk(P[BASE + 0], P[BASE + 1]), a1 = cvtpk(P[BASE + 2], P[BASE + 3]);   \
    unsigned b0 = cvtpk(P[BASE + 4], P[BASE + 5]), b1 = cvtpk(P[BASE + 6], P[BASE + 7]);                              \
    auto r0 = __builtin_amdgcn_permlane32_swap(a0, b0, false, false); auto r1 = __builtin_amdgcn_permlane32_swap(a1, b1, false, false); \
    u32x4 w = {r0[0], r1[0], r0[1], r1[1]}; OUT = *reinterpret_cast<bf16x8*>(&w); } while (0)
  PK4(p0, 0, pa0); PK4(p0, 8, pa1); PK4(p1, 0, pa2); PK4(p1, 8, pa3);
#undef PK4
}
__device__ __forceinline__ void qkt(f32x16& p0, f32x16& p1, const char* Ks, const bf16x8* qr, int r32, int hi) {
  p0 = f32x16{}; p1 = f32x16{};
#pragma unroll
  for (int d0 = 0; d0 < 6; ++d0) { const int cb = (d0 * 16 + hi * 8) * 2;
    const bf16x8 b0 = *reinterpret_cast<const bf16x8*>(Ks + r32 * KROW + cb);
    const bf16x8 b1 = *reinterpret_cast<const bf16x8*>(Ks + (32 + r32) * KROW + cb);
    p0 = __builtin_amdgcn_mfma_f32_32x32x16_bf16(b0, qr[d0], p0, 0, 0, 0);
    p1 = __builtin_amdgcn_mfma_f32_32x32x16_bf16(b1, qr[d0], p1, 0, 0, 0); }
}
__device__ __forceinline__ int v_st(int k, int c) { const int kk = (k & ~0xC) | ((k & 4) << 1) | ((k & 8) >> 1); return ((kk >> 3) * 2 + (c >> 5)) * 512 + ((kk & 7) * 32 + (c & 31)) * 2; }
__device__ __forceinline__ int v_rd_base(int lane) { return ((lane & 3) << 3) | (((lane >> 2) & 3) << 6) | (((lane >> 4) & 1) << 5) | (((lane >> 5) & 1) << 8); }
constexpr int v_rd_off(int d0, int ks, int half) { return d0 * 512 + ks * 2048 + half * 1024; }
template <int OFF> __device__ __forceinline__ s16x4 tr_read(int vb) {
  s16x4 r; asm volatile("ds_read_b64_tr_b16 %0, %1 offset:%2" : "=&v"(r) : "v"(vb), "i"(OFF) : "memory"); return r;
}
template <int D0> __device__ __forceinline__ void pv_one(f32x16& od, int vb, bf16x8 pa0, bf16x8 pa1, bf16x8 pa2, bf16x8 pa3) {
  const s16x4 l0 = tr_read<v_rd_off(D0, 0, 0)>(vb), h0 = tr_read<v_rd_off(D0, 0, 1)>(vb), l1 = tr_read<v_rd_off(D0, 1, 0)>(vb), h1 = tr_read<v_rd_off(D0, 1, 1)>(vb);
  const s16x4 l2 = tr_read<v_rd_off(D0, 2, 0)>(vb), h2 = tr_read<v_rd_off(D0, 2, 1)>(vb), l3 = tr_read<v_rd_off(D0, 3, 0)>(vb), h3 = tr_read<v_rd_off(D0, 3, 1)>(vb);
  asm volatile("s_waitcnt lgkmcnt(0)" ::: "memory"); ASBAR();
#define PK(L, H) (bf16x8){L[0], L[1], L[2], L[3], H[0], H[1], H[2], H[3]}
  od = __builtin_amdgcn_mfma_f32_32x32x16_bf16(pa0, PK(l0, h0), od, 0, 0, 0);
  od = __builtin_amdgcn_mfma_f32_32x32x16_bf16(pa1, PK(l1, h1), od, 0, 0, 0);
  od = __builtin_amdgcn_mfma_f32_32x32x16_bf16(pa2, PK(l2, h2), od, 0, 0, 0);
  od = __builtin_amdgcn_mfma_f32_32x32x16_bf16(pa3, PK(l3, h3), od, 0, 0, 0);
#undef PK
}
__device__ __forceinline__ void pv_d0(f32x16* o, int vb, bf16x8 pa0, bf16x8 pa1, bf16x8 pa2, bf16x8 pa3) {
  pv_one<0>(o[0], vb, pa0, pa1, pa2, pa3); pv_one<1>(o[1], vb, pa0, pa1, pa2, pa3);
}
__device__ __forceinline__ void attn_unit(const bf16_t* __restrict__ Qb, const bf16_t* __restrict__ Kh, const bf16_t* __restrict__ Vh, bf16_t* __restrict__ Ob, int seq, char* lds) {
  const int tid = threadIdx.x, wid = __builtin_amdgcn_readfirstlane(tid >> 6), lane = tid & 63, r32 = lane & 31, hi = lane >> 5;
  char* V_lds = lds; char* K_lds = lds + 2 * SHM_V;
  float* ws = (float*)(lds + LDS_WS) + wid * 64; float* li_l = ws; float* al_l = ws + 32;
  float m_reg = -1e30f, l_reg = 0; f32x16 o[2] = {}; bf16x8 qr[6];
  const bf16_t* Qw = Qb + (long)(wid * QBLK + r32) * 768 + hi * 8;
#pragma unroll
  for (int d0 = 0; d0 < 6; ++d0) qr[d0] = *reinterpret_cast<const bf16x8*>(Qw + d0 * 16);
  const int vrow = tid >> 3, vcol = (tid & 7) * 8, vst = v_st(vrow, vcol);
  const int kr0 = tid / 12, kc0 = tid % 12, kr1 = (512 + (tid & 255)) / 12, kc1 = (512 + (tid & 255)) % 12;
  const bool k2 = wid < 4;
  const int vb0 = (int)(uintptr_t)V_lds + v_rd_base(lane);
  struct { bf16x8 vs, ks0, ks1; } sr_[2];
#define SLOAD(i, k0) do { sr_[i].vs = *reinterpret_cast<const bf16x8*>(&Vh[(long)((k0) + vrow) * 512 + vcol]); \
    sr_[i].ks0 = *reinterpret_cast<const bf16x8*>(&Kh[(long)((k0) + kr0) * 768 + kc0 * 8]); \
    if (k2) sr_[i].ks1 = *reinterpret_cast<const bf16x8*>(&Kh[(long)((k0) + kr1) * 768 + kc1 * 8]); } while (0)
#define SWRITE(b, i) do { *(bf16x8*)(V_lds + (b) * SHM_V + vst) = sr_[i].vs; \
    *(bf16x8*)(K_lds + (b) * SHM_K + kr0 * KROW + kc0 * 16) = sr_[i].ks0; \
    if (k2) *(bf16x8*)(K_lds + (b) * SHM_K + kr1 * KROW + kc1 * 16) = sr_[i].ks1; } while (0)
#define SWAIT() do { if (k2) asm volatile("s_waitcnt vmcnt(3)" ::: "memory"); else asm volatile("s_waitcnt vmcnt(2)" ::: "memory"); } while (0)
#define RESC(a) do { if (__any((a) < 1.f)) { if (hi == 0) al_l[r32] = (a); asm volatile("s_waitcnt lgkmcnt(0)" ::: "memory"); \
    _Pragma("unroll") for (int d = 0; d < 2; ++d) _Pragma("unroll") for (int r = 0; r < 16; ++r) o[d][r] *= al_l[crow(r, hi)]; } } while (0)
  f32x16 pA0, pA1, pB0, pB1; float alA, alB; bf16x8 pa0, pa1, pa2, pa3; const int NT = seq / KVBLK;
  constexpr int SE = 0, SO = 1;
  SLOAD(SE, 0); asm volatile("s_waitcnt vmcnt(0)" ::: "memory"); SWRITE(0, SE); __syncthreads();
  qkt(pA0, pA1, K_lds, qr, r32, hi); partialSM(pA0, pA1, m_reg, alA);
  SLOAD(SO, KVBLK); if (2 < NT) SLOAD(SE, 2 * KVBLK);
  SWAIT(); SWRITE(1, SO); __syncthreads();
  for (int j = 1; j + 1 < NT; j += 2) {
    ASBAR(); qkt(pB0, pB1, K_lds + SHM_K, qr, r32, hi);
    finishSM(pA0, pA1, alA, l_reg, pa0, pa1, pa2, pa3); ASBAR();
    SLOAD(SO, (j + 2) * KVBLK); ASBAR();
    pv_d0(o, vb0, pa0, pa1, pa2, pa3); partialSM(pB0, pB1, m_reg, alB);
    __syncthreads(); SWAIT(); SWRITE(0, SE);
    RESC(alB); __syncthreads();
    ASBAR(); qkt(pA0, pA1, K_lds, qr, r32, hi);
    finishSM(pB0, pB1, alB, l_reg, pa0, pa1, pa2, pa3); ASBAR();
    if (j + 3 < NT) SLOAD(SE, (j + 3) * KVBLK); ASBAR();
    pv_d0(o, vb0 + SHM_V, pa0, pa1, pa2, pa3); partialSM(pA0, pA1, m_reg, alA);
    __syncthreads(); SWAIT(); SWRITE(1, SO);
    RESC(alA); __syncthreads();
  }
  ASBAR(); qkt(pB0, pB1, K_lds + SHM_K, qr, r32, hi);
  finishSM(pA0, pA1, alA, l_reg, pa0, pa1, pa2, pa3); ASBAR();
  pv_d0(o, vb0, pa0, pa1, pa2, pa3); partialSM(pB0, pB1, m_reg, alB);
  __syncthreads(); RESC(alB);
  finishSM(pB0, pB1, alB, l_reg, pa0, pa1, pa2, pa3); ASBAR();
  pv_d0(o, vb0 + SHM_V, pa0, pa1, pa2, pa3);
  if (hi == 0) li_l[r32] = l_reg; asm volatile("s_waitcnt lgkmcnt(0)" ::: "memory");
  float rli[16];
#pragma unroll
  for (int r = 0; r < 16; ++r) rli[r] = __builtin_amdgcn_rcpf(li_l[crow(r, hi)]);
  bf16_t* Ow = Ob + (long)(wid * QBLK) * 1024;
#pragma unroll
  for (int r = 0; r < 16; ++r) { const int orow = crow(r, hi);
#pragma unroll
    for (int d0 = 0; d0 < 2; ++d0) Ow[(long)orow * 1024 + d0 * 32 + r32] = (bf16_t)(cvtpk(o[d0][r] * rli[r], 0.f) & 0xffffu); }
  __syncthreads();
#undef SLOAD
#undef SWRITE
#undef SWAIT
#undef RESC
}
#undef ASBAR
}
#define GAS __attribute__((address_space(1)))
#define LAS __attribute__((address_space(3)))
typedef unsigned short bf16;
typedef unsigned v4u __attribute__((ext_vector_type(4)));
typedef float f32x4 __attribute__((ext_vector_type(4)));
typedef short bf16x8 __attribute__((ext_vector_type(8)));
typedef GAS unsigned gu32;
typedef GAS unsigned long long gu64;
#define RLX_AGENT __ATOMIC_RELAXED, __HIP_MEMORY_SCOPE_AGENT
#define LDS_WAIT() asm volatile("s_waitcnt lgkmcnt(0)" ::: "memory")
#define VM_WAIT() asm volatile("s_waitcnt vmcnt(0)" ::: "memory")
__device__ __forceinline__ unsigned long long rt() { return __builtin_amdgcn_s_memrealtime(); }
__device__ __forceinline__ unsigned f2bf(float f) { unsigned u = __builtin_bit_cast(unsigned, f); return (u + 0x7fffu + ((u >> 16) & 1u)) >> 16; }
__device__ __forceinline__ unsigned pk2(float lo, float hi) { return f2bf(lo) | (f2bf(hi) << 16); }

#define XB_TMO      128
#define XB_XCNT(j)  (256  + 64 * (j))
#define XB_XSUB(j)  (1280 + 64 * (j))
#define XB_XGEN(j)  (2304 + 64 * (j))
#define XB_TOP      3328
#define XB_TOPGEN   3392
#define XCD_BAR_WORDS 3456
#define XB_SPIN_CAP (1u << 18)

__device__ __forceinline__ unsigned xb_ld(unsigned* p)              { return __hip_atomic_load(p, __ATOMIC_RELAXED, __HIP_MEMORY_SCOPE_AGENT); }
__device__ __forceinline__ unsigned xb_add(unsigned* p, unsigned v) { return __hip_atomic_fetch_add(p, v, __ATOMIC_RELAXED, __HIP_MEMORY_SCOPE_AGENT); }
__device__ __forceinline__ unsigned xb_xcc_id() { return (unsigned)__builtin_amdgcn_s_getreg((3 << 11) | 20) & 0xFu; }
#define XB_SPIN(cond, bar) do { unsigned _sp = 0; while (cond) { __builtin_amdgcn_s_sleep(1); \
    if ((++_sp & 255u) == 0u) { if (xb_ld(&(bar)[XB_TMO])) break; if (_sp > XB_SPIN_CAP) { atomicAdd(&(bar)[XB_TMO], 1u); break; } } } } while (0)

struct XcdBarrier {
    unsigned* bar; unsigned x;
    volatile LAS unsigned* st;
};

__device__ __forceinline__ XcdBarrier xcd_barrier_post(unsigned* bar, volatile LAS unsigned* st) {
    XcdBarrier b; b.bar = bar; b.x = xb_xcc_id(); b.st = st;
    if (threadIdx.x == 0) (void)xb_add(&bar[XB_XCNT(b.x)], 1u);
    return b;
}
__device__ __forceinline__ void xcd_barrier_complete(unsigned* bar, unsigned x, unsigned& nloc, unsigned& nx) {
    const unsigned G = gridDim.x * gridDim.y * gridDim.z;
    unsigned sum, cnt, mine, sp = 0u;
    for (;;) {
        sum = 0u; cnt = 0u; mine = 0u;
#pragma unroll
        for (unsigned j = 0; j < 16; ++j) { const unsigned c = xb_ld(&bar[XB_XCNT(j)]); sum += c; cnt += (c > 0u) ? 1u : 0u; mine = (j == x) ? c : mine; }
        if (sum == G) break;
        __builtin_amdgcn_s_sleep(1);
        if ((++sp & 255u) == 0u) { if (xb_ld(&bar[XB_TMO])) break; if (sp > XB_SPIN_CAP) { atomicAdd(&bar[XB_TMO], 1u); break; } }
    }
    nloc = mine > 0u ? mine : 1u; nx = cnt > 0u ? cnt : 1u;
}

__device__ __forceinline__ void xcd_barrier(const XcdBarrier& b) {
    asm volatile("s_waitcnt vmcnt(0)" ::: "memory");
    __syncthreads();
    if (threadIdx.x == 0) {
        unsigned* bar = b.bar;
        __builtin_amdgcn_s_waitcnt(0);
        unsigned nloc = b.st[0], nx = b.st[1];
        if (nloc == 0u) { xcd_barrier_complete(bar, b.x, nloc, nx); b.st[0] = nloc; b.st[1] = nx; }
        const unsigned old = xb_add(&bar[XB_XSUB(b.x)], 1u);
        const unsigned gen = old / nloc;
        if (old + 1u == (gen + 1u) * nloc) {
            __builtin_amdgcn_fence(__ATOMIC_RELEASE, "agent");
            asm volatile("s_waitcnt vmcnt(0)" ::: "memory");
            const unsigned og = xb_add(&bar[XB_TOP], 1u);
            const unsigned tg = og / nx;
            if (og + 1u == (tg + 1u) * nx) xb_add(&bar[XB_TOPGEN], 1u);
            else XB_SPIN(xb_ld(&bar[XB_TOPGEN]) == tg, bar);
            __builtin_amdgcn_fence(__ATOMIC_ACQUIRE, "agent");
            xb_add(&bar[XB_XGEN(b.x)], 1u);
            asm volatile("s_waitcnt vmcnt(0)" ::: "memory");
        } else {
            XB_SPIN(xb_ld(&bar[XB_XGEN(b.x)]) == gen, bar);
            __builtin_amdgcn_fence(__ATOMIC_ACQUIRE, "agent");
            asm volatile("s_waitcnt vmcnt(0)" ::: "memory");
        }
    }
    __syncthreads();
}

constexpr int NWAVES = 8;
#ifndef MK_N_LAUNCHES
#define MK_N_LAUNCHES 1
#endif
constexpr int N_PHASES = 10;
constexpr int N_LAUNCHES = MK_N_LAUNCHES;

constexpr size_t MiB = 1u << 20;
constexpr size_t WS_CTL = 0, CTL_ZERO_BYTES = 65536;
constexpr size_t WS_COS = 1 * MiB, WS_SIN = 1 * MiB + 512 * 1024;
constexpr size_t WS_SSQ1 = 2 * MiB, WS_SSQ2 = 3 * MiB, WS_SSQ3 = 4 * MiB;
constexpr size_t WS_W1 = 5 * MiB;
constexpr size_t WS_WUQ = 9 * MiB;
constexpr size_t WS_WUKV = 9 * MiB + 512 * 1024;
constexpr size_t WS_WO = 10 * MiB;
constexpr size_t WS_WUP = 12 * MiB;
constexpr size_t WS_WDN = 23 * MiB;
constexpr size_t WS_WG = 29 * MiB;
constexpr size_t WS_WPJ = 31 * MiB;
constexpr size_t WS_HB = 32 * MiB;
constexpr size_t WS_Z = 64 * MiB;
constexpr size_t WS_Q = 128 * MiB;
constexpr size_t WS_K = 152 * MiB;
constexpr size_t WS_V = 176 * MiB;
constexpr size_t WS_XB = 152 * MiB;
constexpr size_t WS_QN = 192 * MiB, WS_KVN = 200 * MiB, WS_PB = 208 * MiB;
constexpr size_t WS_PP = 216 * MiB;
constexpr size_t WS_END = 248 * MiB;
static_assert(WS_Z + (size_t)M * DFF * 2 <= WS_K && WS_WDN + (size_t)DM * DFF * 2 <= WS_WG, "d_ws map");
constexpr int CW_BAR = 1024;

constexpr int RING_OFF = 0, RING_BYTES = 131072;
constexpr int MISC_OFF = RING_BYTES, HALO_OFF = RING_BYTES + 512, RSTD_OFF = HALO_OFF + 8192;
constexpr int LDS_BYTES = 147456;
static_assert(RSTD_OFF + 6 * 1024 <= LDS_BYTES, "LDS map");

struct Frame {
    LAS unsigned char* lds;
    int tid, lane, wave, vcu, G;
};

__device__ __forceinline__ float wave_sum(float v) {
#pragma unroll
    for (int o = 1; o < 64; o <<= 1) v += __shfl_xor(v, o);
    return v;
}
template <int MAP>
__device__ __forceinline__ void transpose_item(const float* W, int K, int N, bf16* WT, int ldk, const float* gain, LAS float* scr, int item, int lane) {
    const int nblk = N / 32, kb = item / nblk, nb = item % nblk, k0 = 64 * kb, n0 = 32 * nb;
#pragma unroll 8
    for (int i = 0; i < 32; ++i) { const int kk = 2 * i + (lane >> 5); float v = W[(size_t)(k0 + kk) * N + n0 + (lane & 31)]; if (gain) v *= gain[k0 + kk]; scr[kk * 33 + (lane & 31)] = v; }
    LDS_WAIT(); asm volatile("" ::: "memory");
    int r0 = n0;
    if (MAP == 1) { r0 = (n0 < DFF) ? (256 * (n0 / 128) + (n0 % 128)) : (256 * ((n0 - DFF) / 128) + 128 + ((n0 - DFF) % 128)); }
    const int c = lane & 7;
#pragma unroll
    for (int j = 0; j < 4; ++j) { const int n = (lane >> 3) + 8 * j; const LAS float* s = scr + (8 * c) * 33 + n;
        v4u o; o.x = pk2(s[0 * 33], s[1 * 33]); o.y = pk2(s[2 * 33], s[3 * 33]); o.z = pk2(s[4 * 33], s[5 * 33]); o.w = pk2(s[6 * 33], s[7 * 33]);
        *(GAS v4u*)(WT + (size_t)(r0 + n) * ldk + k0 + 8 * c) = o; }
    LDS_WAIT(); asm volatile("" ::: "memory");
}

struct Ptrs {
    const float *x, *p, *g_mix, *w_in, *conv_w, *g_q, *w_uq, *g_kv, *w_ukv, *w_o, *g_ffn, *w_up, *fcw, *fcb, *w_down, *g_ple, *w_gate, *w_proj, *g_final;
    float* out; unsigned char* ws;
};

__device__ __forceinline__ void p0_prologue(Frame& F, const Ptrs& P) {
    unsigned char* ws = P.ws;
    LAS float* scr = (LAS float*)(F.lds + RING_OFF + F.wave * 16384);
    const int gw = F.vcu * NWAVES + F.wave, NGW = F.G * NWAVES;
    constexpr int I_W1 = (DM / 64) * (DIN / 32), I_UQ = (QLORA / 64) * (768 / 32), I_UKV = (KVLORA / 64) * (1024 / 32), I_O = (DM / 64) * (DM / 32),
                  I_UP = (DM / 64) * (NUP / 32), I_DN = (DFF / 64) * (DM / 32), I_G = I_O, I_PJ = (PLE / 64) * (DM / 32);
    constexpr int NITEMS = I_W1 + I_UQ + I_UKV + I_O + I_UP + I_DN + I_G + I_PJ;
    for (int it = gw; it < NITEMS; it += NGW) {
        int r = it;
        if (r < I_UP) { transpose_item<1>(P.w_up, DM, NUP, (bf16*)(ws + WS_WUP), DM, P.g_ffn, scr, r, F.lane); continue; } r -= I_UP;
        if (r < I_DN) { transpose_item<0>(P.w_down, DFF, DM, (bf16*)(ws + WS_WDN), DFF, nullptr, scr, r, F.lane); continue; } r -= I_DN;
        if (r < I_W1) { transpose_item<0>(P.w_in, DM, DIN, (bf16*)(ws + WS_W1), DM, P.g_mix, scr, r, F.lane); continue; } r -= I_W1;
        if (r < I_O) { transpose_item<0>(P.w_o, DM, DM, (bf16*)(ws + WS_WO), DM, nullptr, scr, r, F.lane); continue; } r -= I_O;
        if (r < I_G) { transpose_item<0>(P.w_gate, DM, DM, (bf16*)(ws + WS_WG), DM, P.g_ple, scr, r, F.lane); continue; } r -= I_G;
        if (r < I_PJ) { transpose_item<0>(P.w_proj, PLE, DM, (bf16*)(ws + WS_WPJ), PLE, nullptr, scr, r, F.lane); continue; } r -= I_PJ;
        if (r < I_UQ) { transpose_item<0>(P.w_uq, QLORA, 768, (bf16*)(ws + WS_WUQ), QLORA, P.g_q, scr, r, F.lane); continue; } r -= I_UQ;
        transpose_item<0>(P.w_ukv, KVLORA, 1024, (bf16*)(ws + WS_WUKV), 256, P.g_kv, scr, r, F.lane);
    }
    const int gt = F.vcu * (NWAVES * 64) + F.tid, NGT = F.G * NWAVES * 64;
    const v4u zero4 = {0u, 0u, 0u, 0u};
    for (int i = gt; i < 12288; i += NGT) *(GAS v4u*)(ws + WS_W1 + (size_t)DIN * DM * 2 + (size_t)i * 16) = zero4;
    for (int i = gt; i < 16384; i += NGT) *(GAS v4u*)(ws + WS_WUKV + (size_t)(i >> 4) * 512 + 256 + (size_t)(i & 15) * 16) = zero4;
    for (int i = gt; i < SEQ * 16; i += NGT) {
        const int pos = i >> 4, j = i & 15;
        constexpr float INVF[16] = {1.0f, 0.5623413324356079f, 0.3162277638912201f, 0.17782793939113617f, 0.10000000149011612f, 0.05623413249850273f, 0.03162277489900589f, 0.017782794311642647f,
                                    0.009999999776482582f, 0.005623413249850273f, 0.003162277629598975f, 0.0017782794311642647f, 0.0010000000474974513f, 0.000562341301701963f, 0.0003162277571391314f, 0.00017782794020604342f};
        const float invf = INVF[j];
        const float ang = (float)pos * invf;
        const double t = (double)ang * 0.15915494309189533577;
        const float fr = (float)(t - __builtin_floor(t));
        ((GAS float*)(ws + WS_COS))[i] = __builtin_amdgcn_cosf(fr); ((GAS float*)(ws + WS_SIN))[i] = __builtin_amdgcn_sinf(fr);
    }
    for (int i = gt; i < M * PLE / 8; i += NGT) {
        const f32x4 a = *(const GAS f32x4*)(P.p + (size_t)i * 8), b = *(const GAS f32x4*)(P.p + (size_t)i * 8 + 4);
        v4u o; o.x = pk2(a[0], a[1]); o.y = pk2(a[2], a[3]); o.z = pk2(b[0], b[1]); o.w = pk2(b[2], b[3]);
        *(GAS v4u*)(ws + WS_PB + (size_t)i * 16) = o;
    }
    for (int m = gw; m < M; m += NGW) {
        const GAS f32x4* xr = (const GAS f32x4*)(P.x + (size_t)m * DM) + F.lane;
        f32x4 v[4]; float s = 0.f;
#pragma unroll
        for (int j = 0; j < 4; ++j) { v[j] = xr[64 * j]; s += (v[j].x * v[j].x + v[j].y * v[j].y) + (v[j].z * v[j].z + v[j].w * v[j].w); }
        const float rstd = rsqrtf(wave_sum(s) * (1.f / DM) + EPS);
        GAS unsigned long long* o8 = (GAS unsigned long long*)(ws + WS_HB + (size_t)m * DM * 2) + F.lane;
#pragma unroll
        for (int j = 0; j < 4; ++j) o8[64 * j] = (unsigned long long)pk2(v[j].x * rstd, v[j].y * rstd) | ((unsigned long long)pk2(v[j].z * rstd, v[j].w * rstd) << 32);
    }
}

__device__ __forceinline__ float bf_lo(unsigned w) { return __uint_as_float(w << 16); }
__device__ __forceinline__ float bf_hi(unsigned w) { return __uint_as_float(w & 0xffff0000u); }

__device__ __forceinline__ void p2_mixer_prep(Frame& F, const Ptrs& P) {
    unsigned char* ws = P.ws;
    const int gw = F.vcu * NWAVES + F.wave, NGW = F.G * NWAVES, lane = F.lane;
    const bf16* Z = (const bf16*)(ws + WS_Z);
    float cw0[8], cw1[8], cw2[8];
#pragma unroll
    for (int j = 0; j < 8; ++j) { cw0[j] = P.conv_w[8 * lane + j]; cw1[j] = P.conv_w[CONVW + 8 * lane + j]; cw2[j] = P.conv_w[2 * CONVW + 8 * lane + j]; }
    const float* cosT = (const float*)(ws + WS_COS); const float* sinT = (const float*)(ws + WS_SIN);
    for (int m = gw; m < M; m += NGW) {
        const int t = m & (SEQ - 1);
        const bf16* zr = Z + (size_t)m * DINP;
        const v4u zero4 = {0u, 0u, 0u, 0u};
        const v4u xc1 = *(const GAS v4u*)(zr + 8 * lane), cg1 = *(const GAS v4u*)(zr + 1024 + 8 * lane), bgv = *(const GAS v4u*)(zr + 512 + 8 * lane);
        const v4u xc0 = (t > 0) ? *(const GAS v4u*)(zr - DINP + 8 * lane) : zero4, cg0 = (t > 0) ? *(const GAS v4u*)(zr - DINP + 1024 + 8 * lane) : zero4;
        const v4u xc2 = (t < SEQ - 1) ? *(const GAS v4u*)(zr + DINP + 8 * lane) : zero4, cg2 = (t < SEQ - 1) ? *(const GAS v4u*)(zr + DINP + 1024 + 8 * lane) : zero4;
        v4u yo;
#pragma unroll
        for (int q = 0; q < 4; ++q) {
            const float u0l = bf_lo(xc0[q]) * bf_lo(cg0[q]), u0h = bf_hi(xc0[q]) * bf_hi(cg0[q]);
            const float u1l = bf_lo(xc1[q]) * bf_lo(cg1[q]), u1h = bf_hi(xc1[q]) * bf_hi(cg1[q]);
            const float u2l = bf_lo(xc2[q]) * bf_lo(cg2[q]), u2h = bf_hi(xc2[q]) * bf_hi(cg2[q]);
            const float yl = bf_lo(bgv[q]) * (cw0[2 * q] * u0l + cw1[2 * q] * u1l + cw2[2 * q] * u2l);
            const float yh = bf_hi(bgv[q]) * (cw0[2 * q + 1] * u0h + cw1[2 * q + 1] * u1h + cw2[2 * q + 1] * u2h);
            yo[q] = pk2(yl, yh);
        }
        *(GAS v4u*)(ws + WS_HB + ((size_t)m * DM + 8 * lane) * 2) = yo;
        { const unsigned long long w = *(const GAS unsigned long long*)(zr + 1536 + 4 * lane);
          const float a = bf_lo((unsigned)w), b = bf_hi((unsigned)w), c = bf_lo((unsigned)(w >> 32)), d = bf_hi((unsigned)(w >> 32));
          const float rs = rsqrtf(wave_sum((a * a + b * b) + (c * c + d * d)) * (1.f / QLORA) + EPS);
          *(GAS unsigned long long*)(ws + WS_QN + ((size_t)m * 256 + 4 * lane) * 2) = (unsigned long long)pk2(a * rs, b * rs) | ((unsigned long long)pk2(c * rs, d * rs) << 32); }
        { const unsigned w = *(const GAS unsigned*)(zr + 1792 + 2 * lane);
          const float a = bf_lo(w), b = bf_hi(w);
          const float rs = rsqrtf(wave_sum(a * a + b * b) * (1.f / KVLORA) + EPS);
          *(GAS unsigned*)(ws + WS_KVN + ((size_t)m * 256 + 2 * lane) * 2) = pk2(a * rs, b * rs);
          *(GAS unsigned*)(ws + WS_KVN + ((size_t)m * 256 + 128 + 2 * lane) * 2) = 0u; }
        { const int l = lane & 31, i = l & 15;
          const float xv = __uint_as_float((unsigned)zr[1920 + l] << 16);
          const float pv = __shfl_xor(xv, 16);
          const float c = cosT[t * 16 + i], s = sinT[t * 16 + i];
          const float o = (l < 16) ? (xv * c - pv * s) : (xv * c + pv * s);
          const bf16 ob = (bf16)f2bf(o);
          if (lane < 32) {
#pragma unroll
              for (int h = 0; h < NH; ++h) ((GAS bf16*)(ws + WS_K))[(size_t)m * LDKK + h * QKD + NOPE + l] = ob; }
        }
    }
}

__device__ __forceinline__ void p9_final_norm(Frame& F, const Ptrs& P) {
    const int gw = F.vcu * NWAVES + F.wave, NGW = F.G * NWAVES;
    const float* ssq = (const float*)(P.ws + WS_SSQ3);
    f32x4 g[2][2];
#pragma unroll
    for (int j = 0; j < 2; ++j) { g[j][0] = *(const GAS f32x4*)(P.g_final + 512 * j + 8 * F.lane); g[j][1] = *(const GAS f32x4*)(P.g_final + 512 * j + 8 * F.lane + 4); }
    for (int m = gw; m < M; m += NGW) {
        const float rs = pg8::rstd16(ssq, m);
        const bf16* xr = (const bf16*)(P.ws + WS_HB) + (size_t)m * DM + 8 * F.lane; float* orow = P.out + (size_t)m * DM + 8 * F.lane;
#pragma unroll
        for (int j = 0; j < 2; ++j) { const v4u w = *(const GAS v4u*)(xr + 512 * j);
            const f32x4 a = {bf_lo(w.x), bf_hi(w.x), bf_lo(w.y), bf_hi(w.y)}, b = {bf_lo(w.z), bf_hi(w.z), bf_lo(w.w), bf_hi(w.w)};
            *(GAS f32x4*)(orow + 512 * j) = a * rs * g[j][0]; *(GAS f32x4*)(orow + 512 * j + 4) = b * rs * g[j][1]; }
    }
}

struct Args { const float* in[19]; float* out; unsigned char* ws; int ph_lo, ph_hi; };
__global__ void __launch_bounds__(NWAVES * 64, 2) mk_fwd(Args args) {
    extern __shared__ __attribute__((aligned(16))) unsigned char lds[];
    Frame F;
    F.lds = (LAS unsigned char*)lds;
    F.tid = threadIdx.x; F.lane = F.tid & 63; F.wave = __builtin_amdgcn_readfirstlane(F.tid >> 6);
    F.G = gridDim.x; { const int bx = blockIdx.x; F.vcu = (F.G % 8 == 0) ? (bx % 8) * (F.G / 8) + bx / 8 : bx; }
    Ptrs P;
    P.x = args.in[0]; P.p = args.in[1]; P.g_mix = args.in[2]; P.w_in = args.in[3]; P.conv_w = args.in[4]; P.g_q = args.in[5]; P.w_uq = args.in[6]; P.g_kv = args.in[7];
    P.w_ukv = args.in[8]; P.w_o = args.in[9]; P.g_ffn = args.in[10]; P.w_up = args.in[11]; P.fcw = args.in[12]; P.fcb = args.in[13]; P.w_down = args.in[14];
    P.g_ple = args.in[15]; P.w_gate = args.in[16]; P.w_proj = args.in[17]; P.g_final = args.in[18]; P.out = args.out; P.ws = args.ws;
    unsigned char* ws = args.ws;
    volatile LAS unsigned* MISC = (volatile LAS unsigned*)(F.lds + MISC_OFF);
    if (F.tid < 128) MISC[F.tid] = 0u;
    __syncthreads();
    XcdBarrier bar; bar.bar = (unsigned*)(ws + WS_CTL) + CW_BAR; bar.x = 0; bar.st = nullptr;
    if (N_LAUNCHES == 1) bar = xcd_barrier_post((unsigned*)(ws + WS_CTL) + CW_BAR, MISC + 8);
    const int lo = args.ph_lo, hi = args.ph_hi;
#ifndef PHMASK
#define PHMASK 0x3ff
#endif
#define IN(k) (((PHMASK >> (k)) & 1) && lo <= (k) && (k) < hi)
#ifndef DUPMASK
#define DUPMASK 0
#endif
#define DUP(k) ((DUPMASK >> (k)) & 1)
#define SEAM(k) do { if (IN(k) && IN((k) + 1)) xcd_barrier(bar); } while (0)

    if (IN(0)) { p0_prologue(F, P); if (DUP(0)) p0_prologue(F, P); } SEAM(0);

    if (IN(1)) {
        pg8::Gemm g{(const pg8::bf16_t*)(ws + WS_HB), (const pg8::bf16_t*)(ws + WS_W1), M, DINP, DM}; pg8::DupOrder<pg8::StaticOrder, DUP(1)> S; S.init(M, DINP, F.G, (int)blockIdx.x);
        pg8::EpiStoreBf16 E{(pg8::bf16_t*)(ws + WS_Z), DINP};
        pg8::gemm_phase<pg8::EpiStoreBf16, pg8::DupOrder<pg8::StaticOrder, DUP(1)>, true, true>(F.lds + RING_OFF, g, S, E);
    } SEAM(1);

    if (IN(2)) { p2_mixer_prep(F, P); if (DUP(2)) p2_mixer_prep(F, P); } SEAM(2);

    if (IN(3)) {
#ifndef P3MASK
#define P3MASK 7
#endif
        if (P3MASK & 1) { pg8::Gemm g{(const pg8::bf16_t*)(ws + WS_QN), (const pg8::bf16_t*)(ws + WS_WUQ), M, 768, 256}; pg8::DupOrder<pg8::StaticOrder, DUP(3)> S; S.init(M, 768, F.G, (int)blockIdx.x);
          pg8::EpiQ E{(pg8::bf16_t*)(ws + WS_Q), (const float*)(ws + WS_COS), (const float*)(ws + WS_SIN), QSCALE};
          pg8::gemm_phase<pg8::EpiQ, pg8::DupOrder<pg8::StaticOrder, DUP(3)>, true, true>(F.lds + RING_OFF, g, S, E); }
        if (P3MASK & 2) { pg8::Gemm g{(const pg8::bf16_t*)(ws + WS_KVN), (const pg8::bf16_t*)(ws + WS_WUKV), M, 1024, 256}; pg8::DupOrder<pg8::StaticOrder, DUP(3)> S; S.init(M, 1024, F.G, (int)blockIdx.x);
          pg8::EpiKV E{(pg8::bf16_t*)(ws + WS_K), (pg8::bf16_t*)(ws + WS_V)};
          pg8::gemm_phase<pg8::EpiKV, pg8::DupOrder<pg8::StaticOrder, DUP(3)>, true, true>(F.lds + RING_OFF, g, S, E); }
        if (P3MASK & 4) { pg8::Gemm g{(const pg8::bf16_t*)(ws + WS_PB), (const pg8::bf16_t*)(ws + WS_WPJ), M, 1024, 256}; pg8::DupOrder<pg8::StaticOrder, DUP(3)> S; S.init(M, 1024, F.G, (int)blockIdx.x);
          pg8::EpiStoreBf16 E{(pg8::bf16_t*)(ws + WS_PP), 1024};
          pg8::gemm_phase<pg8::EpiStoreBf16, pg8::DupOrder<pg8::StaticOrder, DUP(3)>, true, true>(F.lds + RING_OFF, g, S, E); }
    } SEAM(3);

    if (IN(4)) {
        static_assert(attn::LDS_BYTES <= RING_BYTES, "attention LDS");
        const int nunits = BATCH * NH * (SEQ / 256);
        for (int i = 0; ; ++i) {
            const int ii = DUP(4) ? (i >> 1) : i;
            const int uidx = (F.G == 256) ? (((F.vcu >> 5) * 2 + ii) * 32 + (F.vcu & 31)) : (ii * F.G + F.vcu);
            if ((F.G == 256 && ii >= 2) || uidx >= nunits) break;
            const int pair = uidx >> 5, qb = uidx & 31, b = pair >> 3, h = pair & 7;
            const size_t row0 = (size_t)b * SEQ;
            attn::attn_unit((const attn::bf16_t*)(ws + WS_Q) + (row0 + qb * 256) * LDQ + h * QKD, (const attn::bf16_t*)(ws + WS_K) + row0 * LDKK + h * QKD,
                            (const attn::bf16_t*)(ws + WS_V) + row0 * LDV + h * VH, (attn::bf16_t*)(ws + WS_HB) + (row0 + qb * 256) * DM + CONVW + h * VH, SEQ, (char*)lds + RING_OFF);
        }
    } SEAM(4);

    if (IN(5)) {
        pg8::Gemm g{(const pg8::bf16_t*)(ws + WS_HB), (const pg8::bf16_t*)(ws + WS_WO), M, DM, DM}; pg8::DupOrder<pg8::StaticOrder, DUP(5)> S; S.init(M, DM, F.G, (int)blockIdx.x);
        pg8::EpiRes<false> E{P.x, nullptr, (pg8::bf16_t*)(ws + WS_XB), (float*)(ws + WS_SSQ1)};
        pg8::gemm_phase<pg8::EpiRes<false>, pg8::DupOrder<pg8::StaticOrder, DUP(5)>, true, true>(F.lds + RING_OFF, g, S, E);
    } SEAM(5);

    if (IN(6)) {
        pg8::Gemm g{(const pg8::bf16_t*)(ws + WS_XB), (const pg8::bf16_t*)(ws + WS_WUP), M, NUP, DM}; pg8::DupOrder<pg8::UpOrder, DUP(6)> S; S.init_up(F.G, (int)blockIdx.x);
        PG8_LAS float* rstd_l = (PG8_LAS float*)(F.lds + RSTD_OFF);
        { pg8::Unit u;
          for (int i = F.tid >> 8; i < 6 && S.pg8::UpOrder::next(i, u); i += 2) rstd_l[i * 256 + (F.tid & 255)] = pg8::rstd16((const float*)(ws + WS_SSQ1), u.arow + (F.tid & 255));
          __syncthreads(); }
        pg8::EpiUp E{(pg8::bf16_t*)(ws + WS_Z), P.fcw, P.fcb, (PG8_LAS float*)(F.lds + HALO_OFF), rstd_l};
        pg8::gemm_phase<pg8::EpiUp, pg8::DupOrder<pg8::UpOrder, DUP(6)>, true, true>(F.lds + RING_OFF, g, S, E);
    } SEAM(6);

    if (IN(7)) {
        pg8::Gemm g{(const pg8::bf16_t*)(ws + WS_Z), (const pg8::bf16_t*)(ws + WS_WDN), M, DM, DFF}; pg8::StaticOrder S; S.init(M, DM, F.G, (int)blockIdx.x);
        pg8::EpiRes<true> E{nullptr, (const pg8::bf16_t*)(ws + WS_XB), (pg8::bf16_t*)(ws + WS_XB), (float*)(ws + WS_SSQ2)};
        pg8::gemm_phase<pg8::EpiRes<true>, pg8::StaticOrder, true, true>(F.lds + RING_OFF, g, S, E);
    } SEAM(7);

    if (IN(8)) {
        pg8::Gemm g{(const pg8::bf16_t*)(ws + WS_XB), (const pg8::bf16_t*)(ws + WS_WG), M, DM, DM}; pg8::StaticOrder S; S.init(M, DM, F.G, (int)blockIdx.x);
        pg8::EpiGate E{(const pg8::bf16_t*)(ws + WS_XB), (pg8::bf16_t*)(ws + WS_HB), (const pg8::bf16_t*)(ws + WS_PP), (const float*)(ws + WS_SSQ2), (float*)(ws + WS_SSQ3)};
        pg8::gemm_phase<pg8::EpiGate, pg8::StaticOrder, true, true>(F.lds + RING_OFF, g, S, E);
    } SEAM(8);

    if (IN(9)) { p9_final_norm(F, P); }
#undef IN
#undef SEAM
}

extern "C" void kernel_launch(void* const* d_in, const int* in_sizes, int n_in, void* d_out, int out_size, void* d_ws, size_t ws_size, hipStream_t stream) {
    static int grid = 0;
    if (grid == 0) {
        if (n_in != 19 || in_sizes[0] != M * DM || out_size != M * DM || ws_size < WS_END) { fprintf(stderr, "kernel_launch: unexpected shapes (n_in %d, in0 %d, out %d, ws %zu)\n", n_in, n_in > 0 ? in_sizes[0] : -1, out_size, ws_size); grid = -1; return; }
        int dev = 0, cus = 0, per_cu = 0;
        if (hipGetDevice(&dev) != hipSuccess || hipDeviceGetAttribute(&cus, hipDeviceAttributeMultiprocessorCount, dev) != hipSuccess) { grid = -1; return; }
        if (hipFuncSetAttribute((const void*)mk_fwd, hipFuncAttributeMaxDynamicSharedMemorySize, LDS_BYTES) != hipSuccess) { fprintf(stderr, "kernel_launch: hipFuncSetAttribute failed\n"); grid = -1; return; }
        if (hipOccupancyMaxActiveBlocksPerMultiprocessor(&per_cu, (const void*)mk_fwd, NWAVES * 64, LDS_BYTES) != hipSuccess || per_cu < 1) { fprintf(stderr, "kernel_launch: occupancy query says %d blocks per CU\n", per_cu); per_cu = 1; }
        (void)hipGetLastError();
        grid = cus;
    }
    if (grid < 0) return;
    if (hipMemsetAsync((char*)d_ws + WS_CTL, 0, CTL_ZERO_BYTES, stream) != hipSuccess) { fprintf(stderr, "kernel_launch: memset failed\n"); return; }
    Args a{};
    for (int i = 0; i < 19; ++i) a.in[i] = (const float*)d_in[i];
    a.out = (float*)d_out; a.ws = (unsigned char*)d_ws;
    if (N_LAUNCHES == 1) {
        a.ph_lo = 0; a.ph_hi = N_PHASES;
        void* kargs[] = {&a};
        hipError_t e = hipLaunchCooperativeKernel((const void*)mk_fwd, dim3(grid), dim3(NWAVES * 64), kargs, LDS_BYTES, stream);
        if (e != hipSuccess) fprintf(stderr, "kernel_launch: cooperative launch failed: %s (grid %d)\n", hipGetErrorString(e), grid);
    } else {
        for (int li = 0; li < N_PHASES; ++li) {
            a.ph_lo = li; a.ph_hi = li + 1;
            hipLaunchKernelGGL(mk_fwd, dim3(grid), dim3(NWAVES * 64), LDS_BYTES, stream, a);
        }
        const hipError_t le = hipPeekAtLastError();
        if (le != hipSuccess) fprintf(stderr, "kernel_launch: launch failed: %s\n", hipGetErrorName(le));
    }
}
```

```cpp
#include <hip/hip_runtime.h>
#include <hip/hip_bf16.h>
#include <cstdio>
#include <cstdint>
#include <cmath>

constexpr int BATCH = 2, SEQ = 8192, DM = 1024, M = BATCH * SEQ;
constexpr int PLE = 256, CONVW = 512, NH = 8, QLORA = 256, KVLORA = 128, NOPE = 64, ROPE = 32, VH = 64, QKD = 96;
constexpr int DIN = 1952, DINP = 2048, DFF = 2816, NUP = 2 * DFF;
constexpr int LDQ = NH * QKD, LDKK = NH * QKD, LDV = NH * VH;
constexpr float EPS = 1e-6f;
constexpr float QSCALE = 0.10206207261596575f * 1.4426950408889634f;
namespace pg8 {
#define PG8_LAS __attribute__((address_space(3)))
typedef unsigned short bf16_t;
typedef short bf16x8 __attribute__((ext_vector_type(8)));
typedef float f32x4 __attribute__((ext_vector_type(4)));
typedef unsigned u32x4 __attribute__((ext_vector_type(4)));
constexpr int BM = 256, BK = 64, HALF = 128, HTB = HALF * BK * 2  , STAGE_BYTES = 8 * HTB, NXCD = 8, WGM = 8;

__host__ __device__ __forceinline__ int lds_byte(int r, int c) { const int st = (r >> 4) * 2 + (c >> 5), rr = r & 15, cc = c & 31, ob = rr * 64 + cc * 2; return st * 1024 + (ob ^ (((ob >> 9) & 1) << 5)); }
__host__ __device__ __forceinline__ void stage_rc(int b, int& R, int& C) { const int st = b / 1024, sb = b % 1024, swz = sb ^ (((sb >> 9) & 1) << 5); R = (st >> 1) * 16 + swz / 64; C = (st & 1) * 32 + (swz % 64) / 2; }
__host__ __device__ __forceinline__ int perm32(int rho) { const int n = rho >> 4, i = rho & 15; return 8 * (i >> 2) + 4 * n + (i & 3); }

struct Unit { int pm, pn, arow, ord; };
struct Gemm { const bf16_t* A; const bf16_t* Bt; int M, N, K; };

struct StaticOrder {
    int nM, nN, nwg, G, c;
    __host__ __device__ void init(int M, int N, int G_, int c_) { nM = M / BM; nN = N / BM; nwg = nM * nN; G = G_; c = c_; }
    __host__ __device__ bool next(int i, Unit& u) const {
        const long L = (long)i * G + c; if (L >= nwg) return false;
        int wgid = (int)L; { const int q = nwg / NXCD, r = nwg % NXCD, xcd = wgid % NXCD, off = wgid / NXCD; wgid = (xcd < r ? xcd * (q + 1) : r * (q + 1) + (xcd - r) * q) + off; }
        const int nig = WGM * nN, gid = wgid / nig, fm = gid * WGM, gsz = (nM - fm) < WGM ? (nM - fm) : WGM;
        u.pm = fm + ((wgid % nig) % gsz); u.pn = (wgid % nig) / gsz; u.arow = u.pm * BM; u.ord = i; return true;
    }
    __device__ __forceinline__ void a_ready(const Unit&) const {}
    __device__ __forceinline__ void done(const Unit&) const {}
};

__device__ __forceinline__ unsigned cvt_pk_bf16(float lo, float hi) { unsigned r; asm volatile("v_cvt_pk_bf16_f32 %0, %1, %2" : "=v"(r) : "v"(lo), "v"(hi)); return r; }
typedef float f32x2 __attribute__((ext_vector_type(2)));
typedef unsigned u32x2 __attribute__((ext_vector_type(2)));
__device__ __forceinline__ u32x2 pack4(const f32x4 v) { u32x2 w; w.x = cvt_pk_bf16(v[0], v[1]); w.y = cvt_pk_bf16(v[2], v[3]); return w; }
__device__ __forceinline__ u32x4 pack8(const f32x4 a, const f32x4 b) { u32x4 w; w.x = cvt_pk_bf16(a[0], a[1]); w.y = cvt_pk_bf16(a[2], a[3]); w.z = cvt_pk_bf16(b[0], b[1]); w.w = cvt_pk_bf16(b[2], b[3]); return w; }
__device__ __forceinline__ f32x4 unpack4(const u32x2 w) { f32x4 v; v[0] = __uint_as_float(w.x << 16); v[1] = __uint_as_float(w.x & 0xffff0000u); v[2] = __uint_as_float(w.y << 16); v[3] = __uint_as_float(w.y & 0xffff0000u); return v; }
__device__ __forceinline__ float rstd16(const float* ssqp, int row) {
    const f32x4* p = (const f32x4*)(ssqp + (size_t)row * 16); const f32x4 a = p[0], b = p[1], c = p[2], d = p[3];
    const float s = ((a[0] + a[1]) + (a[2] + a[3])) + ((b[0] + b[1]) + (b[2] + b[3])) + ((c[0] + c[1]) + (c[2] + c[3])) + ((d[0] + d[1]) + (d[2] + d[3]));
    return rsqrtf(s * (1.0f / 1024.0f) + 1e-6f);
}


struct EpiStoreBf16 {
    static constexpr bool PERM = true, AFTER_DRAIN = false;
    bf16_t* O; int ldc;
    __device__ __forceinline__ void operator()(f32x4 (&acc)[2][2][4][2], const Unit& u, int wr, int wc, int fr, int fq, int lane) const {
        const int row0 = u.pm * BM + wr * 64 + fr, col0 = u.pn * BM + wc * 32 + 8 * fq;
#pragma unroll
        for (int ai = 0; ai < 2; ++ai)
#pragma unroll
            for (int m = 0; m < 4; ++m) { bf16_t* rowp = O + (size_t)(row0 + ai * HALF + m * 16) * ldc + col0;
#pragma unroll
                for (int bj = 0; bj < 2; ++bj) *(u32x4*)(rowp + bj * HALF) = pack8(acc[ai][bj][m][0], acc[ai][bj][m][1]); }
    }
};

struct EpiP3 {
    static constexpr bool PERM = true, AFTER_DRAIN = false;
    bf16_t* Q; bf16_t* Kb; bf16_t* Vb; bf16_t* PP; const float* cosT; const float* sinT; float scale;
    __device__ __forceinline__ void operator()(f32x4 (&acc)[2][2][4][2], const Unit& u, int wr, int wc, int fr, int fq, int lane) const {
        const int row0 = u.pm * BM + wr * 64 + fr;
        if (u.pn < 3) {
#pragma unroll
            for (int bj = 0; bj < 2; ++bj) {
                const int gc0 = u.pn * BM + bj * HALF + wc * 32;
                const bool rope = (gc0 % 96) == 64;
#pragma unroll
                for (int ai = 0; ai < 2; ++ai)
#pragma unroll
                    for (int m = 0; m < 4; ++m) {
                        const int row = row0 + ai * HALF + m * 16, pos = row & (SEQ - 1);
                        f32x4 v0 = acc[ai][bj][m][0], v1 = acc[ai][bj][m][1];
                        if (rope) { const float* cp = cosT + pos * 16 + 8 * (fq & 1); const float* sp = sinT + pos * 16 + 8 * (fq & 1);
                            const f32x4 c0 = *(const f32x4*)cp, c1 = *(const f32x4*)(cp + 4), s0 = *(const f32x4*)sp, s1 = *(const f32x4*)(sp + 4);
                            f32x4 p0, p1;
#pragma unroll
                            for (int j = 0; j < 4; ++j) { p0[j] = __shfl_xor(v0[j], 32); p1[j] = __shfl_xor(v1[j], 32); }
                            const float sg = (fq < 2) ? -1.0f : 1.0f;
                            v0 = v0 * c0 + p0 * s0 * sg; v1 = v1 * c1 + p1 * s1 * sg; }
                        *(u32x4*)(Q + (size_t)row * 768 + gc0 + 8 * fq) = pack8(v0 * scale, v1 * scale);
                        asm volatile("" ::: "memory");
                    }
            }
        } else if (u.pn < 7) {
#pragma unroll
            for (int bj = 0; bj < 2; ++bj) {
                const int head = 2 * (u.pn - 3) + bj, within = wc * 32 + 8 * fq;
                bf16_t* base = (wc < 2) ? (Kb + head * 96 + within) : (Vb + head * 64 + (within - 64));
                const int ld = (wc < 2) ? 768 : 512;
#pragma unroll
                for (int ai = 0; ai < 2; ++ai)
#pragma unroll
                    for (int m = 0; m < 4; ++m) { const int row = row0 + ai * HALF + m * 16;
                        *(u32x4*)(base + (size_t)row * ld) = pack8(acc[ai][bj][m][0], acc[ai][bj][m][1]); }
            }
        } else {
            const int col0 = (u.pn - 7) * BM + wc * 32 + 8 * fq;
#pragma unroll
            for (int ai = 0; ai < 2; ++ai)
#pragma unroll
                for (int m = 0; m < 4; ++m) { bf16_t* rowp = PP + (size_t)(row0 + ai * HALF + m * 16) * 1024 + col0;
#pragma unroll
                    for (int bj = 0; bj < 2; ++bj) *(u32x4*)(rowp + bj * HALF) = pack8(acc[ai][bj][m][0], acc[ai][bj][m][1]); }
        }
    }
};
struct P3Order {
    int G, c;
    __host__ __device__ bool next(int i, Unit& u) const {
        const int L = i * G + c; if (L >= 11 * 64) return false;
        u.pn = L >> 6; u.pm = L & 63; u.ord = i;
        const int which = (u.pn < 3) ? 0 : (u.pn < 7 ? 1 : 2);
        u.arow = which * M + u.pm * BM; return true;
    }
    __device__ __forceinline__ void a_ready(const Unit&) const {}
    __device__ __forceinline__ void done(const Unit&) const {}
};

template <bool RESB> struct EpiRes {
    static constexpr bool PERM = false, AFTER_DRAIN = false;
    const float* resf; const bf16_t* resb; bf16_t* xb; float* ssqp;
    __device__ __forceinline__ void operator()(f32x4 (&acc)[2][2][4][2], const Unit& u, int wr, int wc, int fr, int fq, int lane) const {
        const int col0 = u.pn * BM + wc * 32 + 4 * fq;
#pragma unroll
        for (int ai = 0; ai < 2; ++ai)
#pragma unroll
            for (int m = 0; m < 4; ++m) {
                const int row = u.pm * BM + ai * HALF + wr * 64 + m * 16 + fr; const size_t off = (size_t)row * 1024 + col0; float ss = 0.f;
#pragma unroll
                for (int bj = 0; bj < 2; ++bj)
#pragma unroll
                    for (int n = 0; n < 2; ++n) { const size_t o = off + bj * HALF + n * 16;
                        const f32x4 r = RESB ? unpack4(*(const u32x2*)(resb + o)) : *(const f32x4*)(resf + o); const f32x4 v = r + acc[ai][bj][m][n];
                        *(u32x2*)(xb + o) = pack4(v); ss += (v[0] * v[0] + v[1] * v[1]) + (v[2] * v[2] + v[3] * v[3]); }
                ss += __shfl_xor(ss, 16); ss += __shfl_xor(ss, 32);
                if (fq == 0) ssqp[(size_t)row * 16 + u.pn * 4 + wc] = ss;
                asm volatile("" ::: "memory");
            }
    }
};

struct EpiGate {
    static constexpr bool PERM = false, AFTER_DRAIN = false;
    const bf16_t* x2; bf16_t* out; const bf16_t* pp; const float* ssq2p; float* ssq3p;
    __device__ __forceinline__ void operator()(f32x4 (&acc)[2][2][4][2], const Unit& u, int wr, int wc, int fr, int fq, int lane) const {
        const int col0 = u.pn * BM + wc * 32 + 4 * fq;
#pragma unroll
        for (int ai = 0; ai < 2; ++ai)
#pragma unroll
            for (int m = 0; m < 4; ++m) {
                const int row = u.pm * BM + ai * HALF + wr * 64 + m * 16 + fr; const size_t off = (size_t)row * 1024 + col0; float ss = 0.f;
                const float rs = rstd16(ssq2p, row);
#pragma unroll
                for (int bj = 0; bj < 2; ++bj)
#pragma unroll
                    for (int n = 0; n < 2; ++n) { const size_t o = off + bj * HALF + n * 16; const f32x4 a = acc[ai][bj][m][n] * rs; f32x4 g;
#pragma unroll
                        for (int j = 0; j < 4; ++j) g[j] = __builtin_amdgcn_rcpf(1.0f + __expf(-a[j]));
                        const f32x4 v = unpack4(*(const u32x2*)(x2 + o)) + g * unpack4(*(const u32x2*)(pp + o));
                        *(u32x2*)(out + o) = pack4(v); ss += (v[0] * v[0] + v[1] * v[1]) + (v[2] * v[2] + v[3] * v[3]); }
                ss += __shfl_xor(ss, 16); ss += __shfl_xor(ss, 32);
                if (fq == 0) ssq3p[(size_t)row * 16 + u.pn * 4 + wc] = ss;
                asm volatile("" ::: "memory");
            }
    }
};

__device__ __forceinline__ float dpp_ror1(float v) { return __builtin_bit_cast(float, __builtin_amdgcn_update_dpp(0, __builtin_bit_cast(int, v), 0x121, 0xf, 0xf, false)); }
__device__ __forceinline__ float dpp_ror15(float v) { return __builtin_bit_cast(float, __builtin_amdgcn_update_dpp(0, __builtin_bit_cast(int, v), 0x12F, 0xf, 0xf, false)); }
__device__ __forceinline__ f32x4 ror1v(const f32x4 v) { f32x4 r; r[0] = dpp_ror1(v[0]); r[1] = dpp_ror1(v[1]); r[2] = dpp_ror1(v[2]); r[3] = dpp_ror1(v[3]); return r; }
__device__ __forceinline__ f32x4 ror15v(const f32x4 v) { f32x4 r; r[0] = dpp_ror15(v[0]); r[1] = dpp_ror15(v[1]); r[2] = dpp_ror15(v[2]); r[3] = dpp_ror15(v[3]); return r; }
struct EpiUp {
    static constexpr bool PERM = true, AFTER_DRAIN = false;
    bf16_t* H; const float* cw; const float* cb; PG8_LAS float* halo; const PG8_LAS float* rstd;
    __device__ __forceinline__ void operator()(f32x4 (&acc)[2][2][4][2], const Unit& u, int wr, int wc, int fr, int fq, int lane) const {
        const int s = u.arow & (SEQ - 1); const bool first = (s == 0), last = (s + 256 == SEQ);
        const int ch0 = wc * 32 + 8 * fq;
#pragma unroll
        for (int ai = 0; ai < 2; ++ai)
#pragma unroll
            for (int m = 0; m < 4; ++m) { const float rs = rstd[u.ord * 256 + ai * HALF + wr * 64 + m * 16 + fr];
#pragma unroll
                for (int bj = 0; bj < 2; ++bj)
#pragma unroll
                    for (int n = 0; n < 2; ++n) acc[ai][bj][m][n] = acc[ai][bj][m][n] * rs; }
#pragma unroll
        for (int ai = 0; ai < 2; ++ai) { const int seg = 2 * ai + wr;
            if (fr == 0) {
#pragma unroll
                for (int bj = 0; bj < 2; ++bj)
#pragma unroll
                    for (int n = 0; n < 2; ++n) *(PG8_LAS f32x4*)(halo + (seg * 2 + 0) * 256 + bj * HALF + ch0 + 4 * n) = acc[ai][bj][0][n]; }
            if (fr == 15) {
#pragma unroll
                for (int bj = 0; bj < 2; ++bj)
#pragma unroll
                    for (int n = 0; n < 2; ++n) *(PG8_LAS f32x4*)(halo + (seg * 2 + 1) * 256 + bj * HALF + ch0 + 4 * n) = acc[ai][bj][3][n]; }
        }
        asm volatile("s_waitcnt lgkmcnt(0)" ::: "memory"); __builtin_amdgcn_s_barrier(); asm volatile("" ::: "memory");
        const f32x4 z4 = {0.f, 0.f, 0.f, 0.f};
#pragma unroll
        for (int n = 0; n < 2; ++n) {
            const int gch = u.pn * 128 + ch0 + 4 * n;
            const f32x4 wg0 = *(const f32x4*)(cw + gch), wg1 = *(const f32x4*)(cw + NUP + gch), wg2 = *(const f32x4*)(cw + 2 * NUP + gch), bg = *(const f32x4*)(cb + gch);
            const f32x4 wu0 = *(const f32x4*)(cw + DFF + gch), wu1 = *(const f32x4*)(cw + NUP + DFF + gch), wu2 = *(const f32x4*)(cw + 2 * NUP + DFF + gch), bu = *(const f32x4*)(cb + DFF + gch);
#pragma unroll
            for (int ai = 0; ai < 2; ++ai) {
                const int seg = 2 * ai + wr, sup = seg > 0 ? seg - 1 : 0, sdn = seg < 3 ? seg + 1 : 3;
#pragma unroll
                for (int m = 0; m < 4; ++m) {
                    const int r = ai * HALF + wr * 64 + m * 16 + fr, t = s + r;
                    f32x4 pg, pu, ng, nu;
                    if (m == 0) { pg = *(const PG8_LAS f32x4*)(halo + (sup * 2 + 1) * 256 + ch0 + 4 * n); pu = *(const PG8_LAS f32x4*)(halo + (sup * 2 + 1) * 256 + HALF + ch0 + 4 * n); }
                    else { pg = acc[ai][0][m > 0 ? m - 1 : 0][n]; pu = acc[ai][1][m > 0 ? m - 1 : 0][n]; }
                    if (m == 3) { ng = *(const PG8_LAS f32x4*)(halo + (sdn * 2 + 0) * 256 + ch0 + 4 * n); nu = *(const PG8_LAS f32x4*)(halo + (sdn * 2 + 0) * 256 + HALF + ch0 + 4 * n); }
                    else { ng = acc[ai][0][m < 3 ? m + 1 : 3][n]; nu = acc[ai][1][m < 3 ? m + 1 : 3][n]; }
                    const f32x4 vg = acc[ai][0][m][n], vu = acc[ai][1][m][n];
                    f32x4 upg = ror1v(fr == 15 ? pg : vg), upu = ror1v(fr == 15 ? pu : vu), dng = ror15v(fr == 0 ? ng : vg), dnu = ror15v(fr == 0 ? nu : vu);
                    if (t == 0) { upg = z4; upu = z4; }
                    if (t == SEQ - 1) { dng = z4; dnu = z4; }
                    const f32x4 ag = wg0 * upg + wg1 * vg + wg2 * dng + bg, au = wu0 * upu + wu1 * vu + wu2 * dnu + bu;
                    f32x4 hv;
#pragma unroll
                    for (int j = 0; j < 4; ++j) hv[j] = ag[j] * __builtin_amdgcn_rcpf(1.0f + __expf(-ag[j])) * au[j];
                    if ((r > 0 || first) && (r < 255 || last)) *(u32x2*)(H + (size_t)(u.arow + r) * DFF + u.pn * 128 + ch0 + 4 * n) = pack4(hv);
                }
            }
        }
    }
};
struct UpOrder : StaticOrder {
    __host__ __device__ void init_up(int G_, int c_) { nM = 66; nN = 22; nwg = nM * nN; G = G_; c = c_; }
    __host__ __device__ bool next(int i, Unit& u) const {
        if (!StaticOrder::next(i, u)) return false;
        const int b = u.pm / 33, k = u.pm % 33; int st = 254 * k; if (st > SEQ - 256) st = SEQ - 256;
        u.arow = b * SEQ + st; u.ord = i; return true;
    }
};
template <class Base, int D> struct DupOrder : Base {
    __host__ __device__ bool next(int i, Unit& u) const { return Base::next(D ? (i >> 1) : i, u); }
};
template <class Epi, class Sched, bool ALIGN_EPI = false, bool SP2 = false>
__device__ __forceinline__ void gemm_phase(PG8_LAS unsigned char* lds, const Gemm g, const Sched& S, const Epi& E) {
    const int tid = threadIdx.x, wid = __builtin_amdgcn_readfirstlane(tid >> 6), lane = tid & 63, wr = wid >> 2, wc = wid & 3, fr = lane & 15, fq = lane >> 4;
    int K_ = g.K; asm volatile("" : "+s"(K_));
    const int K = K_, nt = K / BK;
    unsigned voffA[2], voffB[2];
#pragma unroll
    for (int i = 0; i < 2; ++i) { int R, C; stage_rc(tid * 16 + i * 8192, R, C); const int Rb = Epi::PERM ? ((R & ~31) + perm32(R & 31)) : R;
        voffA[i] = (unsigned)(R * K + C) * 2u; voffB[i] = (unsigned)(Rb * K + C) * 2u; }
    const size_t kstep = (size_t)(BK * 2);
    const size_t hstep = (size_t)HALF * K * 2;
    const size_t rstep = (size_t)K * 2;
    const size_t tstep = 2 * hstep;
    const unsigned ldsw = (unsigned)wid * 1024u;
    const int aoff = lds_byte(wr * 64 + fr, fq * 8), boff = lds_byte(wc * 32 + fr, fq * 8);
#define PG8_SA(b, h) (((b) * 2 + (h)) * HTB)
#define PG8_SB(b, h) ((4 + (b) * 2 + (h)) * HTB)
#define PG8_STAGE(bufoff, gbase, voff) do { _Pragma("unroll") for (int _i = 0; _i < 2; ++_i) \
        __builtin_amdgcn_global_load_lds((const unsigned*)((const char*)(gbase) + (voff)[_i]), (PG8_LAS unsigned*)(lds + (bufoff) + ldsw + _i * 8192), 16, 0, 0); } while (0)
#define PG8_LDA(dst, b, h) do { _Pragma("unroll") for (int m = 0; m < 4; ++m) _Pragma("unroll") for (int k = 0; k < 2; ++k) dst[m][k] = *(const PG8_LAS bf16x8*)(lds + PG8_SA(b, h) + aoff + m * 2048 + k * 1024); } while (0)
#define PG8_LDB(dst, b, h) do { _Pragma("unroll") for (int n = 0; n < 2; ++n) _Pragma("unroll") for (int k = 0; k < 2; ++k) dst[n][k] = *(const PG8_LAS bf16x8*)(lds + PG8_SB(b, h) + boff + n * 2048 + k * 1024); } while (0)
#define PG8_MMA(ai, bj, At, Bt) do { __builtin_amdgcn_s_setprio(1); _Pragma("unroll") for (int m = 0; m < 4; ++m) _Pragma("unroll") for (int n = 0; n < 2; ++n) _Pragma("unroll") for (int k = 0; k < 2; ++k) \
        acc[ai][bj][m][n] = __builtin_amdgcn_mfma_f32_16x16x32_bf16(Bt[n][k], At[m][k], acc[ai][bj][m][n], 0, 0, 0); __builtin_amdgcn_s_setprio(0); } while (0)
#define PG8_WAIT_V(n) asm volatile("s_waitcnt vmcnt(" #n ")" ::: "memory")
#define PG8_WAIT_L(n) asm volatile("s_waitcnt lgkmcnt(" #n ")" ::: "memory")
#define PG8_BAR __builtin_amdgcn_s_barrier()
#define PG8_SCHED __builtin_amdgcn_sched_barrier(0)
    Unit cur, nxt; int ui = 0;
    if (!S.next(0, cur)) return;
    f32x4 acc[2][2][4][2];
#pragma unroll
    for (int a = 0; a < 2; ++a)
#pragma unroll
        for (int b = 0; b < 2; ++b)
#pragma unroll
            for (int m = 0; m < 4; ++m)
#pragma unroll
                for (int n = 0; n < 2; ++n) acc[a][b][m][n] = (f32x4){0.f, 0.f, 0.f, 0.f};
    bf16x8 At[4][2], B0[2][2], B1[2][2];
    const char* cA = (const char*)g.A + (size_t)cur.arow * rstep; const char* cB = (const char*)g.Bt + (size_t)cur.pn * tstep;
    S.a_ready(cur);
    if constexpr (SP2) {
        PG8_STAGE(PG8_SB(0, 0), cB, voffB); PG8_STAGE(PG8_SB(0, 1), cB + hstep, voffB); PG8_STAGE(PG8_SA(0, 0), cA, voffA); PG8_STAGE(PG8_SA(0, 1), cA + hstep, voffA);
        if (wr == 1) PG8_BAR;
        PG8_WAIT_V(2); PG8_BAR;
        PG8_STAGE(PG8_SB(1, 0), cB + kstep, voffB); PG8_STAGE(PG8_SA(1, 0), cA + kstep, voffA); PG8_STAGE(PG8_SB(1, 1), cB + hstep + kstep, voffB);
        PG8_WAIT_V(6); PG8_BAR;
    } else {
        PG8_STAGE(PG8_SB(0, 0), cB, voffB); PG8_STAGE(PG8_SA(0, 0), cA, voffA); PG8_STAGE(PG8_SB(0, 1), cB + hstep, voffB); PG8_STAGE(PG8_SA(0, 1), cA + hstep, voffA);
        if (wr == 1) PG8_BAR;
        PG8_WAIT_V(4); PG8_BAR;
        PG8_STAGE(PG8_SB(1, 0), cB + kstep, voffB); PG8_STAGE(PG8_SA(1, 0), cA + kstep, voffA); PG8_STAGE(PG8_SB(1, 1), cB + hstep + kstep, voffB);
        PG8_WAIT_V(6); PG8_BAR;
    }
    for (;;) {
        const bool has_next = S.next(ui + 1, nxt);
        const char* nA = has_next ? (const char*)g.A + (size_t)nxt.arow * rstep : cA; const char* nB = has_next ? (const char*)g.Bt + (size_t)nxt.pn * tstep : cB;
        for (int t = 0; t < nt; t += 2) {
            const bool last = (t == nt - 2);
            const char* a1 = cA + (size_t)(t + 1) * kstep;
            const char* a2 = last ? nA : cA + (size_t)(t + 2) * kstep; const char* b2 = last ? nB : cB + (size_t)(t + 2) * kstep;
            const char* a3 = a2 + kstep; const char* b3 = b2 + kstep;
            if (last && has_next) S.a_ready(nxt);
            if constexpr (SP2) {
            PG8_LDB(B0, 0, 0); PG8_LDB(B1, 0, 1); PG8_SCHED; PG8_LDA(At, 0, 0); PG8_STAGE(PG8_SA(1, 1), a1 + hstep, voffA);
            PG8_WAIT_V(8); PG8_WAIT_L(0); PG8_BAR; PG8_MMA(0, 0, At, B0); PG8_MMA(0, 1, At, B1); PG8_BAR; PG8_SCHED;
            PG8_LDA(At, 0, 1); PG8_STAGE(PG8_SB(0, 0), b2, voffB); PG8_STAGE(PG8_SB(0, 1), b2 + hstep, voffB); PG8_STAGE(PG8_SA(0, 0), a2, voffA);
            PG8_WAIT_V(8); PG8_WAIT_L(0); PG8_BAR; PG8_MMA(1, 0, At, B0); PG8_MMA(1, 1, At, B1); PG8_BAR; PG8_SCHED;
            PG8_LDB(B0, 1, 0); PG8_LDB(B1, 1, 1); PG8_SCHED; PG8_LDA(At, 1, 0); PG8_STAGE(PG8_SA(0, 1), a2 + hstep, voffA);
            PG8_WAIT_V(8); PG8_WAIT_L(0); PG8_BAR; PG8_MMA(0, 0, At, B0); PG8_MMA(0, 1, At, B1); PG8_BAR; PG8_SCHED;
            PG8_LDA(At, 1, 1); PG8_STAGE(PG8_SB(1, 0), b3, voffB); PG8_STAGE(PG8_SB(1, 1), b3 + hstep, voffB); PG8_STAGE(PG8_SA(1, 0), a3, voffA);
            PG8_WAIT_V(8); PG8_WAIT_L(0); PG8_BAR; PG8_MMA(1, 0, At, B0); PG8_MMA(1, 1, At, B1); PG8_BAR; PG8_SCHED;
            } else {
            PG8_LDB(B0, 0, 0); PG8_SCHED; PG8_LDA(At, 0, 0); PG8_STAGE(PG8_SA(1, 1), a1 + hstep, voffA);
            PG8_WAIT_L(8); PG8_BAR; PG8_WAIT_L(0); PG8_MMA(0, 0, At, B0); PG8_BAR; PG8_SCHED;
            PG8_LDB(B1, 0, 1); PG8_STAGE(PG8_SB(0, 0), b2, voffB);
            PG8_BAR; PG8_WAIT_L(0); PG8_MMA(0, 1, At, B1); PG8_BAR;
            PG8_LDA(At, 0, 1); PG8_STAGE(PG8_SA(0, 0), a2, voffA);
            PG8_BAR; PG8_WAIT_L(0); PG8_MMA(1, 0, At, B0); PG8_BAR; PG8_SCHED;
            PG8_STAGE(PG8_SB(0, 1), b2 + hstep, voffB);
            PG8_WAIT_V(6); PG8_BAR; PG8_MMA(1, 1, At, B1); PG8_BAR;
            PG8_LDB(B0, 1, 0); PG8_SCHED; PG8_LDA(At, 1, 0); PG8_STAGE(PG8_SA(0, 1), a2 + hstep, voffA);
            PG8_WAIT_L(8); PG8_BAR; PG8_WAIT_L(0); PG8_MMA(0, 0, At, B0); PG8_BAR; PG8_SCHED;
            PG8_LDB(B1, 1, 1); PG8_STAGE(PG8_SB(1, 0), b3, voffB);
            PG8_BAR; PG8_WAIT_L(0); PG8_MMA(0, 1, At, B1); PG8_BAR;
            PG8_LDA(At, 1, 1); PG8_STAGE(PG8_SA(1, 0), a3, voffA);
            PG8_BAR; PG8_WAIT_L(0); PG8_MMA(1, 0, At, B0); PG8_BAR; PG8_SCHED;
            PG8_STAGE(PG8_SB(1, 1), b3 + hstep, voffB);
            PG8_WAIT_V(6); PG8_BAR; PG8_MMA(1, 1, At, B1); PG8_BAR;
            }
        }
        if constexpr (ALIGN_EPI) { if (wr == 0) PG8_BAR; }
        if constexpr (!Epi::AFTER_DRAIN) { E(acc, cur, wr, wc, fr, fq, lane); S.done(cur); }
        if (!has_next) break;
#pragma unroll
        for (int a = 0; a < 2; ++a)
#pragma unroll
            for (int b = 0; b < 2; ++b)
#pragma unroll
                for (int m = 0; m < 4; ++m)
#pragma unroll
                    for (int n = 0; n < 2; ++n) acc[a][b][m][n] = (f32x4){0.f, 0.f, 0.f, 0.f};
        cur = nxt; cA = nA; cB = nB; ++ui;
        if constexpr (ALIGN_EPI) { if (wr == 1) PG8_BAR; }
    }
    PG8_WAIT_V(0);
    if constexpr (!ALIGN_EPI) { if (wr == 0) PG8_BAR; }
    PG8_BAR;
    if constexpr (Epi::AFTER_DRAIN) { E.fused(acc, cur, wr, wc, fr, fq, lds, wid, lane); S.done(cur); }
#undef PG8_SA
#undef PG8_SB
#undef PG8_STAGE
#undef PG8_LDA
#undef PG8_LDB
#undef PG8_MMA
#undef PG8_WAIT_V
#undef PG8_WAIT_L
#undef PG8_BAR
#undef PG8_SCHED
}
}
namespace attn {
using bf16x8 = __attribute__((ext_vector_type(8))) short;
using s16x4  = __attribute__((ext_vector_type(4))) short;
using f32x16 = __attribute__((ext_vector_type(16))) float;
using u32x4  = __attribute__((ext_vector_type(4))) unsigned;
typedef unsigned short bf16_t;
typedef short v4i16_t __attribute__((ext_vector_type(4)));
#define ALAS __attribute__((address_space(3)))
constexpr int NW = 8, QBLK = 32, KVBLK = 64;
constexpr int KSLOT = 12 * 1024, VSLOT = 8 * 1024, LDS_K = 0, LDS_V = 3 * KSLOT, LDS_WS = LDS_V + 3 * VSLOT, LDS_BYTES = LDS_WS + NW * 64 * 4;
constexpr float THR = 8.f;
#define ASBAR() __builtin_amdgcn_sched_barrier(0)
__device__ __forceinline__ int crow(int r, int hi) { return (r & 3) + 8 * (r >> 2) + 4 * hi; }
typedef float f32x2_t __attribute__((ext_vector_type(2))); typedef __bf16 bf16x2_t __attribute__((ext_vector_type(2)));
__device__ __forceinline__ unsigned cvtpk(float lo, float hi) { f32x2_t v = {lo, hi}; bf16x2_t b = __builtin_convertvector(v, bf16x2_t); return __builtin_bit_cast(unsigned, b); }
__device__ __forceinline__ s16x4 vtr(const ALAS char* p) { return __builtin_bit_cast(s16x4, __builtin_amdgcn_ds_read_tr16_b64_v4i16((ALAS v4i16_t*)p)); }

#define APIN(x) asm volatile("" : "+v"(x))
__device__ __forceinline__ void blockA(f32x16& c0, f32x16& c1, const ALAS char* kp, const bf16x8* qr, const f32x16& negm,
                                       const f32x16& p0, const f32x16& p1, float& l_reg, u32x4& pw0, u32x4& pw1, u32x4& pw2, u32x4& pw3,
                                       const ALAS char* vp, s16x4& v0l, s16x4& v0h, s16x4& v1l, s16x4& v1h) {
  bf16x8 kf[12];
#pragma unroll
  for (int d0 = 0; d0 < 6; ++d0) { kf[2 * d0] = *(const ALAS bf16x8*)(kp + d0 * 2048); kf[2 * d0 + 1] = *(const ALAS bf16x8*)(kp + d0 * 2048 + 512); }
  ASBAR();
  float sacc = 0.f;
#define GAPA(MF, A0, A1, A2, A3, W0, W1, PW) do { MF; sacc += A0; sacc += A1; sacc += A2; sacc += A3; APIN(sacc); W0; W1; APIN(PW); ASBAR(); } while (0)
  GAPA(c0 = __builtin_amdgcn_mfma_f32_32x32x16_bf16(kf[0], qr[0], negm, 0, 0, 0), p0[0], p0[1], p0[2], p0[3],     pw0[0] = cvtpk(p0[0], p0[1]),   pw0[1] = cvtpk(p0[2], p0[3]), pw0);
  GAPA(c1 = __builtin_amdgcn_mfma_f32_32x32x16_bf16(kf[1], qr[0], negm, 0, 0, 0), p0[4], p0[5], p0[6], p0[7],     pw0[2] = cvtpk(p0[4], p0[5]),   pw0[3] = cvtpk(p0[6], p0[7]), pw0);
  GAPA(c0 = __builtin_amdgcn_mfma_f32_32x32x16_bf16(kf[2], qr[1], c0, 0, 0, 0),   p0[8], p0[9], p0[10], p0[11],   pw1[0] = cvtpk(p0[8], p0[9]),   pw1[1] = cvtpk(p0[10], p0[11]), pw1);
  GAPA(c1 = __builtin_amdgcn_mfma_f32_32x32x16_bf16(kf[3], qr[1], c1, 0, 0, 0),   p0[12], p0[13], p0[14], p0[15], pw1[2] = cvtpk(p0[12], p0[13]), pw1[3] = cvtpk(p0[14], p0[15]), pw1);
  GAPA(c0 = __builtin_amdgcn_mfma_f32_32x32x16_bf16(kf[4], qr[2], c0, 0, 0, 0),   p1[0], p1[1], p1[2], p1[3],     pw2[0] = cvtpk(p1[0], p1[1]),   pw2[1] = cvtpk(p1[2], p1[3]), pw2);
  GAPA(c1 = __builtin_amdgcn_mfma_f32_32x32x16_bf16(kf[5], qr[2], c1, 0, 0, 0),   p1[4], p1[5], p1[6], p1[7],     pw2[2] = cvtpk(p1[4], p1[5]),   pw2[3] = cvtpk(p1[6], p1[7]), pw2);
  GAPA(c0 = __builtin_amdgcn_mfma_f32_32x32x16_bf16(kf[6], qr[3], c0, 0, 0, 0),   p1[8], p1[9], p1[10], p1[11],   pw3[0] = cvtpk(p1[8], p1[9]),   pw3[1] = cvtpk(p1[10], p1[11]), pw3);
  GAPA(c1 = __builtin_amdgcn_mfma_f32_32x32x16_bf16(kf[7], qr[3], c1, 0, 0, 0),   p1[12], p1[13], p1[14], p1[15], pw3[2] = cvtpk(p1[12], p1[13]), pw3[3] = cvtpk(p1[14], p1[15]), pw3);
#undef GAPA
  l_reg += sacc;
  c0 = __builtin_amdgcn_mfma_f32_32x32x16_bf16(kf[8], qr[4], c0, 0, 0, 0);  v0l = vtr(vp); ASBAR();
  c1 = __builtin_amdgcn_mfma_f32_32x32x16_bf16(kf[9], qr[4], c1, 0, 0, 0);  v0h = vtr(vp + 512); ASBAR();
  c0 = __builtin_amdgcn_mfma_f32_32x32x16_bf16(kf[10], qr[5], c0, 0, 0, 0); v1l = vtr(vp + 4096); ASBAR();
  c1 = __builtin_amdgcn_mfma_f32_32x32x16_bf16(kf[11], qr[5], c1, 0, 0, 0); v1h = vtr(vp + 4096 + 512); ASBAR();
}
__device__ __forceinline__ float rowmax(const f32x16& p0, const f32x16& p1) {
  float a = __builtin_fmaxf(__builtin_fmaxf(p0[0], p0[1]), p1[0]), b = __builtin_fmaxf(__builtin_fmaxf(p0[2], p0[3]), p1[1]); a = __builtin_fmaxf(__builtin_fmaxf(a, p1[2]), p1[3]);
#pragma unroll
  for (int r = 4; r < 16; r += 4) { a = __builtin_fmaxf(__builtin_fmaxf(a, p0[r]), p0[r + 1]); b = __builtin_fmaxf(__builtin_fmaxf(b, p0[r + 2]), p0[r + 3]);
    a = __builtin_fmaxf(__builtin_fmaxf(a, p1[r]), p1[r + 1]); b = __builtin_fmaxf(__builtin_fmaxf(b, p1[r + 2]), p1[r + 3]); }
  const float m = __builtin_fmaxf(a, b);
  auto rr = __builtin_amdgcn_permlane32_swap(__float_as_uint(m), __float_as_uint(m), false, false);
  return __builtin_fmaxf(__uint_as_float(rr[0]), __uint_as_float(rr[1]));
}
__device__ __forceinline__ void blockB(f32x16* o, const ALAS char* vp, const u32x4& pw0, const u32x4& pw1, const u32x4& pw2, const u32x4& pw3, f32x16& c0, f32x16& c1,
                                       s16x4 v0l, s16x4 v0h, s16x4 v1l, s16x4 v1h) {
#define VPK(L, H) (bf16x8){L[0], L[1], L[2], L[3], H[0], H[1], H[2], H[3]}
#define EX4(X, B) do { X[B] = __builtin_amdgcn_exp2f(X[B]); X[B + 1] = __builtin_amdgcn_exp2f(X[B + 1]); X[B + 2] = __builtin_amdgcn_exp2f(X[B + 2]); X[B + 3] = __builtin_amdgcn_exp2f(X[B + 3]); APIN(X); } while (0)
  s16x4 v2l, v2h, v3l, v3h;
  v2l = vtr(vp + 1024); v2h = vtr(vp + 1024 + 512); ASBAR();
  o[0] = __builtin_amdgcn_mfma_f32_32x32x16_bf16(__builtin_bit_cast(bf16x8, pw0), VPK(v0l, v0h), o[0], 0, 0, 0); EX4(c0, 0);  v3l = vtr(vp + 4096 + 1024); v3h = vtr(vp + 4096 + 1024 + 512); ASBAR();
  o[1] = __builtin_amdgcn_mfma_f32_32x32x16_bf16(__builtin_bit_cast(bf16x8, pw0), VPK(v1l, v1h), o[1], 0, 0, 0); EX4(c0, 4);  v0l = vtr(vp + 2048); v0h = vtr(vp + 2048 + 512); ASBAR();
  o[0] = __builtin_amdgcn_mfma_f32_32x32x16_bf16(__builtin_bit_cast(bf16x8, pw1), VPK(v2l, v2h), o[0], 0, 0, 0); EX4(c0, 8);  v1l = vtr(vp + 4096 + 2048); v1h = vtr(vp + 4096 + 2048 + 512); ASBAR();
  o[1] = __builtin_amdgcn_mfma_f32_32x32x16_bf16(__builtin_bit_cast(bf16x8, pw1), VPK(v3l, v3h), o[1], 0, 0, 0); EX4(c0, 12); v2l = vtr(vp + 3072); v2h = vtr(vp + 3072 + 512); ASBAR();
  o[0] = __builtin_amdgcn_mfma_f32_32x32x16_bf16(__builtin_bit_cast(bf16x8, pw2), VPK(v0l, v0h), o[0], 0, 0, 0); EX4(c1, 0);  v3l = vtr(vp + 4096 + 3072); v3h = vtr(vp + 4096 + 3072 + 512); ASBAR();
  o[1] = __builtin_amdgcn_mfma_f32_32x32x16_bf16(__builtin_bit_cast(bf16x8, pw2), VPK(v1l, v1h), o[1], 0, 0, 0); EX4(c1, 4);  ASBAR();
  o[0] = __builtin_amdgcn_mfma_f32_32x32x16_bf16(__builtin_bit_cast(bf16x8, pw3), VPK(v2l, v2h), o[0], 0, 0, 0); EX4(c1, 8);  ASBAR();
  o[1] = __builtin_amdgcn_mfma_f32_32x32x16_bf16(__builtin_bit_cast(bf16x8, pw3), VPK(v3l, v3h), o[1], 0, 0, 0); EX4(c1, 12); ASBAR();
#undef VPK
#undef EX4
}
__device__ __forceinline__ void attn_unit(const bf16_t* __restrict__ Qb, const bf16_t* __restrict__ Kh, const bf16_t* __restrict__ Vh, bf16_t* __restrict__ Ob, int seq, ALAS char* lds) {
  const int tid = threadIdx.x, wid = __builtin_amdgcn_readfirstlane(tid >> 6), lane = tid & 63, r32 = lane & 31, hi = lane >> 5;
  ALAS float* wsf = (ALAS float*)(lds + LDS_WS) + wid * 64;
  bf16x8 qr[6];
  const bf16_t* Qw = Qb + (long)(wid * QBLK + r32) * 768 + hi * 8;
#pragma unroll
  for (int d0 = 0; d0 < 6; ++d0) qr[d0] = *reinterpret_cast<const bf16x8*>(Qw + d0 * 16);
  const bool k2 = wid < 4;
  const bf16_t* ksrc0 = Kh + (long)lane * 768 + wid * 8; const bf16_t* ksrc1 = Kh + (long)lane * 768 + (8 + (wid & 3)) * 8;
  const bf16_t* vsrc = Vh + (long)(16 * (wid & 3) + (lane >> 2)) * 512 + (wid >> 2) * 32 + (lane & 3) * 8;
  ALAS char* kdst0 = lds + LDS_K + wid * 1024 + lane * 16; ALAS char* kdst1 = lds + LDS_K + (8 + (wid & 3)) * 1024 + lane * 16; ALAS char* vdst = lds + LDS_V + wid * 1024 + lane * 16;
  const ALAS char* kp0 = lds + LDS_K + hi * 1024 + r32 * 16;
  const ALAS char* vp0 = lds + LDS_V + ((lane >> 4) & 1) * 32 + (lane & 3) * 8 + (4 * hi + ((lane & 15) >> 2)) * 64;
  bf16x8 sk0, sk1, sv;
#define SLOAD(t) do { sk0 = *reinterpret_cast<const bf16x8*>(ksrc0 + (long)(t) * (KVBLK * 768)); if (k2) sk1 = *reinterpret_cast<const bf16x8*>(ksrc1 + (long)(t) * (KVBLK * 768)); \
    sv = *reinterpret_cast<const bf16x8*>(vsrc + (long)(t) * (KVBLK * 512)); } while (0)
#define SWRITE(ko, vo) do { *(ALAS bf16x8*)(kdst0 + (ko)) = sk0; if (k2) *(ALAS bf16x8*)(kdst1 + (ko)) = sk1; *(ALAS bf16x8*)(vdst + (vo)) = sv; } while (0)
#define BAR() do { asm volatile("s_waitcnt lgkmcnt(0)" ::: "memory"); __builtin_amdgcn_s_barrier(); asm volatile("" ::: "memory"); } while (0)
  float mhat = 0.f, l_reg = 0.f; f32x16 o[2]; o[0] = f32x16{}; o[1] = f32x16{}; f32x16 negm = f32x16{};
  bool resc = false;
#define DECIDE(C0, C1) do { const float rm = rowmax(C0, C1); resc = false; \
    if (__builtin_expect(__any(rm > THR), 0)) { const float dl = __builtin_fmaxf(rm, 0.f); mhat += dl; \
      _Pragma("unroll") for (int r = 0; r < 16; ++r) { C0[r] -= dl; C1[r] -= dl; } \
      _Pragma("unroll") for (int r = 0; r < 16; ++r) negm[r] = -mhat; \
      const float f = __builtin_amdgcn_exp2f(-dl); l_reg *= f; if (hi == 0) wsf[r32] = f; resc = true; } } while (0)
#define RESC() do { if (resc) { asm volatile("s_waitcnt lgkmcnt(0)" ::: "memory"); \
    _Pragma("unroll") for (int d = 0; d < 2; ++d) _Pragma("unroll") for (int r = 0; r < 16; ++r) o[d][r] *= wsf[crow(r, hi)]; } } while (0)
  f32x16 pA0, pA1, pB0, pB1; u32x4 pw0, pw1, pw2, pw3; const int NT = seq / KVBLK;
  int ko_cur = 0, ko_nxt = KSLOT, vo_prev = 0, vo_cur = 0, vo_nxt = VSLOT;
#define ROT() do { ko_cur = ko_nxt; ko_nxt = (ko_nxt == 2 * KSLOT) ? 0 : ko_nxt + KSLOT; vo_prev = vo_cur; vo_cur = vo_nxt; vo_nxt = (vo_nxt == 2 * VSLOT) ? 0 : vo_nxt + VSLOT; } while (0)
  SLOAD(0); SWRITE(0, 0); SLOAD(1); BAR();
  s16x4 v0l, v0h, v1l, v1h;
  { const f32x16 z = f32x16{}; u32x4 d0_, d1_, d2_, d3_; float ld_ = 0.f;
    blockA(pA0, pA1, kp0, qr, negm, z, z, ld_, d0_, d1_, d2_, d3_, vp0, v0l, v0h, v1l, v1h); }
  { const float rm = rowmax(pA0, pA1); mhat = rm;
#pragma unroll
    for (int r = 0; r < 16; ++r) { pA0[r] -= rm; pA1[r] -= rm; negm[r] = -rm; } }
#pragma unroll
  for (int r = 0; r < 16; ++r) { pA0[r] = __builtin_amdgcn_exp2f(pA0[r]); pA1[r] = __builtin_amdgcn_exp2f(pA1[r]); }
  SWRITE(ko_nxt, vo_nxt); BAR(); ROT();
#define STEP(CN0, CN1, PP0, PP1, jj) do { \
    if ((jj) + 1 < NT) SLOAD((jj) + 1); \
    ASBAR(); blockA(CN0, CN1, kp0 + ko_cur, qr, negm, PP0, PP1, l_reg, pw0, pw1, pw2, pw3, vp0 + vo_prev, v0l, v0h, v1l, v1h); ASBAR(); \
    DECIDE(CN0, CN1); ASBAR(); \
    blockB(o, vp0 + vo_prev, pw0, pw1, pw2, pw3, CN0, CN1, v0l, v0h, v1l, v1h); ASBAR(); \
    if ((jj) + 1 < NT) SWRITE(ko_nxt, vo_nxt); \
    RESC(); BAR(); ROT(); } while (0)
  int j = 1;
  for (; j + 1 < NT; j += 2) { STEP(pB0, pB1, pA0, pA1, j); STEP(pA0, pA1, pB0, pB1, j + 1); }
  STEP(pB0, pB1, pA0, pA1, j);
  { float s0 = 0.f;
#pragma unroll
    for (int r = 0; r < 16; ++r) s0 += pB0[r] + pB1[r];
    l_reg += s0;
    pw0 = (u32x4){cvtpk(pB0[0], pB0[1]), cvtpk(pB0[2], pB0[3]), cvtpk(pB0[4], pB0[5]), cvtpk(pB0[6], pB0[7])};
    pw1 = (u32x4){cvtpk(pB0[8], pB0[9]), cvtpk(pB0[10], pB0[11]), cvtpk(pB0[12], pB0[13]), cvtpk(pB0[14], pB0[15])};
    pw2 = (u32x4){cvtpk(pB1[0], pB1[1]), cvtpk(pB1[2], pB1[3]), cvtpk(pB1[4], pB1[5]), cvtpk(pB1[6], pB1[7])};
    pw3 = (u32x4){cvtpk(pB1[8], pB1[9]), cvtpk(pB1[10], pB1[11]), cvtpk(pB1[12], pB1[13]), cvtpk(pB1[14], pB1[15])};
    const ALAS char* vp = vp0 + vo_prev;
#define VFR(dh, ks) ({ const s16x4 lo_ = vtr(vp + (dh) * 4096 + (ks) * 1024), hi_ = vtr(vp + (dh) * 4096 + (ks) * 1024 + 512); (bf16x8){lo_[0], lo_[1], lo_[2], lo_[3], hi_[0], hi_[1], hi_[2], hi_[3]}; })
#pragma unroll
    for (int dh = 0; dh < 2; ++dh) {
      o[dh] = __builtin_amdgcn_mfma_f32_32x32x16_bf16(__builtin_bit_cast(bf16x8, pw0), VFR(dh, 0), o[dh], 0, 0, 0);
      o[dh] = __builtin_amdgcn_mfma_f32_32x32x16_bf16(__builtin_bit_cast(bf16x8, pw1), VFR(dh, 1), o[dh], 0, 0, 0);
      o[dh] = __builtin_amdgcn_mfma_f32_32x32x16_bf16(__builtin_bit_cast(bf16x8, pw2), VFR(dh, 2), o[dh], 0, 0, 0);
      o[dh] = __builtin_amdgcn_mfma_f32_32x32x16_bf16(__builtin_bit_cast(bf16x8, pw3), VFR(dh, 3), o[dh], 0, 0, 0); }
#undef VFR
  }
  { auto rr = __builtin_amdgcn_permlane32_swap(__float_as_uint(l_reg), __float_as_uint(l_reg), false, false); l_reg = __uint_as_float(rr[0]) + __uint_as_float(rr[1]); }
  if (hi == 0) wsf[32 + r32] = l_reg; asm volatile("s_waitcnt lgkmcnt(0)" ::: "memory");
  float rli[16];
#pragma unroll
  for (int r = 0; r < 16; ++r) rli[r] = __builtin_amdgcn_rcpf(wsf[32 + crow(r, hi)]);
  bf16_t* Ow = Ob + (long)(wid * QBLK) * 1024;
#pragma unroll
  for (int r = 0; r < 16; ++r) { const int orow = crow(r, hi);
#pragma unroll
    for (int d0 = 0; d0 < 2; ++d0) Ow[(long)orow * 1024 + d0 * 32 + r32] = (bf16_t)(cvtpk(o[d0][r] * rli[r], 0.f) & 0xffffu); }
  BAR();
#undef SLOAD
#undef SWRITE
#undef BAR
#undef DECIDE
#undef RESC
#undef ROT
#undef STEP
}
#undef ASBAR
}
#define GAS __attribute__((address_space(1)))
#define LAS __attribute__((address_space(3)))
typedef unsigned short bf16;
typedef unsigned v4u __attribute__((ext_vector_type(4)));
typedef float f32x4 __attribute__((ext_vector_type(4)));
typedef short bf16x8 __attribute__((ext_vector_type(8)));
typedef GAS unsigned gu32;
typedef GAS unsigned long long gu64;
#define RLX_AGENT __ATOMIC_RELAXED, __HIP_MEMORY_SCOPE_AGENT
#define LDS_WAIT() asm volatile("s_waitcnt lgkmcnt(0)" ::: "memory")
#define VM_WAIT() asm volatile("s_waitcnt vmcnt(0)" ::: "memory")
__device__ __forceinline__ unsigned long long rt() { return __builtin_amdgcn_s_memrealtime(); }
__device__ __forceinline__ unsigned f2bf(float f) { unsigned u = __builtin_bit_cast(unsigned, f); return (u + 0x7fffu + ((u >> 16) & 1u)) >> 16; }
__device__ __forceinline__ unsigned pk2(float lo, float hi) { return f2bf(lo) | (f2bf(hi) << 16); }

#define XB_TMO      128
#define XB_XCNT(j)  (256  + 64 * (j))
#define XB_XSUB(j)  (1280 + 64 * (j))
#define XB_XGEN(j)  (2304 + 64 * (j))
#define XB_TOP      3328
#define XB_TOPGEN   3392
#define XCD_BAR_WORDS 3456
#define XB_SPIN_CAP (1u << 18)

__device__ __forceinline__ unsigned xb_ld(unsigned* p)              { return __hip_atomic_load(p, __ATOMIC_RELAXED, __HIP_MEMORY_SCOPE_AGENT); }
__device__ __forceinline__ unsigned xb_add(unsigned* p, unsigned v) { return __hip_atomic_fetch_add(p, v, __ATOMIC_RELAXED, __HIP_MEMORY_SCOPE_AGENT); }
__device__ __forceinline__ unsigned xb_xcc_id() { return (unsigned)__builtin_amdgcn_s_getreg((3 << 11) | 20) & 0xFu; }
#define XB_SPIN(cond, bar) do { unsigned _sp = 0; while (cond) { __builtin_amdgcn_s_sleep(1); \
    if ((++_sp & 255u) == 0u) { if (xb_ld(&(bar)[XB_TMO])) break; if (_sp > XB_SPIN_CAP) { atomicAdd(&(bar)[XB_TMO], 1u); break; } } } } while (0)

struct XcdBarrier {
    unsigned* bar; unsigned x;
    volatile LAS unsigned* st;
};

__device__ __forceinline__ XcdBarrier xcd_barrier_post(unsigned* bar, volatile LAS unsigned* st) {
    XcdBarrier b; b.bar = bar; b.x = xb_xcc_id(); b.st = st;
    if (threadIdx.x == 0) (void)xb_add(&bar[XB_XCNT(b.x)], 1u);
    return b;
}
__device__ __forceinline__ void xcd_barrier_complete(unsigned* bar, unsigned x, unsigned& nloc, unsigned& nx) {
    const unsigned G = gridDim.x * gridDim.y * gridDim.z;
    unsigned sum, cnt, mine, sp = 0u;
    for (;;) {
        sum = 0u; cnt = 0u; mine = 0u;
#pragma unroll
        for (unsigned j = 0; j < 16; ++j) { const unsigned c = xb_ld(&bar[XB_XCNT(j)]); sum += c; cnt += (c > 0u) ? 1u : 0u; mine = (j == x) ? c : mine; }
        if (sum == G) break;
        __builtin_amdgcn_s_sleep(1);
        if ((++sp & 255u) == 0u) { if (xb_ld(&bar[XB_TMO])) break; if (sp > XB_SPIN_CAP) { atomicAdd(&bar[XB_TMO], 1u); break; } }
    }
    nloc = mine > 0u ? mine : 1u; nx = cnt > 0u ? cnt : 1u;
}

__device__ __forceinline__ void xcd_barrier(const XcdBarrier& b) {
    asm volatile("s_waitcnt vmcnt(0)" ::: "memory");
    __syncthreads();
    if (threadIdx.x == 0) {
        unsigned* bar = b.bar;
        __builtin_amdgcn_s_waitcnt(0);
        unsigned nloc = b.st[0], nx = b.st[1];
        if (nloc == 0u) { xcd_barrier_complete(bar, b.x, nloc, nx); b.st[0] = nloc; b.st[1] = nx; }
        const unsigned old = xb_add(&bar[XB_XSUB(b.x)], 1u);
        const unsigned gen = old / nloc;
        if (old + 1u == (gen + 1u) * nloc) {
            __builtin_amdgcn_fence(__ATOMIC_RELEASE, "agent");
            asm volatile("s_waitcnt vmcnt(0)" ::: "memory");
            const unsigned og = xb_add(&bar[XB_TOP], 1u);
            const unsigned tg = og / nx;
            if (og + 1u == (tg + 1u) * nx) xb_add(&bar[XB_TOPGEN], 1u);
            else XB_SPIN(xb_ld(&bar[XB_TOPGEN]) == tg, bar);
            __builtin_amdgcn_fence(__ATOMIC_ACQUIRE, "agent");
            xb_add(&bar[XB_XGEN(b.x)], 1u);
            asm volatile("s_waitcnt vmcnt(0)" ::: "memory");
        } else {
            XB_SPIN(xb_ld(&bar[XB_XGEN(b.x)]) == gen, bar);
            __builtin_amdgcn_fence(__ATOMIC_ACQUIRE, "agent");
            asm volatile("s_waitcnt vmcnt(0)" ::: "memory");
        }
    }
    __syncthreads();
}

constexpr int NWAVES = 8;
#ifndef MK_N_LAUNCHES
#define MK_N_LAUNCHES 1
#endif
#ifndef MK_COOP
#define MK_COOP 1
#endif
constexpr int N_PHASES = 10;
constexpr int N_LAUNCHES = MK_N_LAUNCHES;

constexpr size_t MiB = 1u << 20;
constexpr size_t WS_CTL = 0, CTL_ZERO_BYTES = 65536;
constexpr size_t WS_COS = 1 * MiB, WS_SIN = 1 * MiB + 512 * 1024;
constexpr size_t WS_SSQ1 = 2 * MiB, WS_SSQ2 = 3 * MiB, WS_SSQ3 = 4 * MiB;
constexpr size_t WS_W1 = 5 * MiB;
constexpr size_t WS_WUQ = 9 * MiB;
constexpr size_t WS_WUKV = WS_WUQ + 768 * 512;
constexpr size_t WS_WO = 29 * MiB;
constexpr size_t WS_WUP = 12 * MiB + 512 * 1024;
constexpr size_t WS_WDN = 23 * MiB + 512 * 1024;
constexpr size_t WS_WG = 10 * MiB + 512 * 1024;
constexpr size_t WS_WPJ = WS_WUKV + 1024 * 512;
constexpr size_t WS_HB = 32 * MiB;
constexpr size_t WS_Z = 64 * MiB;
constexpr size_t WS_Q = 128 * MiB;
constexpr size_t WS_K = 152 * MiB;
constexpr size_t WS_V = 176 * MiB;
constexpr size_t WS_XB = 152 * MiB;
constexpr size_t WS_QN = 192 * MiB, WS_KVN = 200 * MiB, WS_PB = 208 * MiB;
constexpr size_t WS_PP = 216 * MiB;
constexpr size_t WS_END = 248 * MiB;
static_assert(WS_Z + (size_t)M * DFF * 2 <= WS_K && WS_WDN + (size_t)DM * DFF * 2 <= WS_WO && WS_WO + 2 * MiB <= WS_HB && WS_WPJ + 1024 * 512 <= WS_WG && WS_WG + 2 * MiB <= WS_WUP && WS_WUP + 11 * MiB <= WS_WDN, "d_ws map");
static_assert(WS_KVN == WS_QN + (size_t)M * 512 && WS_PB == WS_KVN + (size_t)M * 512, "P3 reads [qn | kvn | pb] as one A operand");
constexpr int CW_BAR = 1024;

constexpr int RING_OFF = 0, RING_BYTES = 131072;
constexpr int MISC_OFF = RING_BYTES, HALO_OFF = RING_BYTES + 512, RSTD_OFF = HALO_OFF + 8192;
constexpr int LDS_BYTES = 147456;
static_assert(RSTD_OFF + 6 * 1024 <= LDS_BYTES, "LDS map");

struct Frame {
    LAS unsigned char* lds;
    int tid, lane, wave, vcu, G;
};

__device__ __forceinline__ float wave_sum(float v) {
#pragma unroll
    for (int o = 1; o < 64; o <<= 1) v += __shfl_xor(v, o);
    return v;
}
struct TrItem { const float* W; bf16* WT; const float* gain; int N, ldk, k0, n0, r0; };
__device__ __forceinline__ void tr_load(const TrItem& t, int lane, f32x4 (&v)[8], float (&gn)[8]) {
    const int n4 = (lane & 7) * 4, kr = lane >> 3;
#pragma unroll
    for (int i = 0; i < 8; ++i) { v[i] = *(const GAS f32x4*)(t.W + (size_t)(t.k0 + kr + 8 * i) * t.N + t.n0 + n4); gn[i] = t.gain ? t.gain[t.k0 + kr + 8 * i] : 1.0f; }
}
__device__ __forceinline__ void tr_store(const TrItem& t, int lane, const f32x4 (&v)[8], const float (&gn)[8], LAS float* scr) {
    const int n4 = (lane & 7) * 4, kr = lane >> 3;
#pragma unroll
    for (int i = 0; i < 8; ++i) { LAS float* d = scr + (kr + 8 * i) * 33 + n4; d[0] = v[i][0] * gn[i]; d[1] = v[i][1] * gn[i]; d[2] = v[i][2] * gn[i]; d[3] = v[i][3] * gn[i]; }
    LDS_WAIT(); asm volatile("" ::: "memory");
    const int c = lane & 7;
#pragma unroll
    for (int j = 0; j < 4; ++j) { const int n = (lane >> 3) + 8 * j; const LAS float* s = scr + (8 * c) * 33 + n;
        v4u o; o.x = pk2(s[0 * 33], s[1 * 33]); o.y = pk2(s[2 * 33], s[3 * 33]); o.z = pk2(s[4 * 33], s[5 * 33]); o.w = pk2(s[6 * 33], s[7 * 33]);
        *(GAS v4u*)(t.WT + (size_t)(t.r0 + n) * t.ldk + t.k0 + 8 * c) = o; }
    LDS_WAIT(); asm volatile("" ::: "memory");
}

struct Ptrs {
    const float *x, *p, *g_mix, *w_in, *conv_w, *g_q, *w_uq, *g_kv, *w_ukv, *w_o, *g_ffn, *w_up, *fcw, *fcb, *w_down, *g_ple, *w_gate, *w_proj, *g_final;
    float* out; unsigned char* ws;
};

__device__ __forceinline__ bool tr_decode(const Ptrs& P, unsigned char* ws, int it, TrItem& t) {
    constexpr int I_W1 = (DM / 64) * (DIN / 32), I_UQ = (QLORA / 64) * (768 / 32), I_UKV = (KVLORA / 64) * (1024 / 32), I_O = (DM / 64) * (DM / 32),
                  I_UP = (DM / 64) * (NUP / 32), I_DN = (DFF / 64) * (DM / 32), I_G = I_O, I_PJ = (PLE / 64) * (DM / 32);
    constexpr int NITEMS = I_W1 + I_UQ + I_UKV + I_O + I_UP + I_DN + I_G + I_PJ;
    if (it >= NITEMS) return false;
    int r = it, map = 0;
    if (r < I_UP) { t.W = P.w_up; t.N = NUP; t.WT = (bf16*)(ws + WS_WUP); t.ldk = DM; t.gain = P.g_ffn; map = 1; }
    else if ((r -= I_UP) < I_DN) { t.W = P.w_down; t.N = DM; t.WT = (bf16*)(ws + WS_WDN); t.ldk = DFF; t.gain = nullptr; }
    else if ((r -= I_DN) < I_W1) { t.W = P.w_in; t.N = DIN; t.WT = (bf16*)(ws + WS_W1); t.ldk = DM; t.gain = P.g_mix; }
    else if ((r -= I_W1) < I_O) { t.W = P.w_o; t.N = DM; t.WT = (bf16*)(ws + WS_WO); t.ldk = DM; t.gain = nullptr; }
    else if ((r -= I_O) < I_G) { t.W = P.w_gate; t.N = DM; t.WT = (bf16*)(ws + WS_WG); t.ldk = DM; t.gain = P.g_ple; }
    else if ((r -= I_G) < I_PJ) { t.W = P.w_proj; t.N = DM; t.WT = (bf16*)(ws + WS_WPJ); t.ldk = PLE; t.gain = nullptr; }
    else if ((r -= I_PJ) < I_UQ) { t.W = P.w_uq; t.N = 768; t.WT = (bf16*)(ws + WS_WUQ); t.ldk = QLORA; t.gain = P.g_q; }
    else { r -= I_UQ; t.W = P.w_ukv; t.N = 1024; t.WT = (bf16*)(ws + WS_WUKV); t.ldk = 256; t.gain = P.g_kv; }
    const int nblk = t.N / 32; t.k0 = 64 * (r / nblk); t.n0 = 32 * (r % nblk);
    t.r0 = map ? ((t.n0 < DFF) ? (256 * (t.n0 / 128) + (t.n0 % 128)) : (256 * ((t.n0 - DFF) / 128) + 128 + ((t.n0 - DFF) % 128))) : t.n0;
    return true;
}
__device__ __forceinline__ void p0_prologue(Frame& F, const Ptrs& P) {
    unsigned char* ws = P.ws;
    LAS float* scr = (LAS float*)(F.lds + RING_OFF + F.wave * 16384);
    const int gw = F.vcu * NWAVES + F.wave, NGW = F.G * NWAVES;
    const int gt = F.vcu * (NWAVES * 64) + F.tid, NGT = F.G * NWAVES * 64;
    for (int m0 = gw; m0 < M; m0 += 4 * NGW) {
        f32x4 v[4][4];
#pragma unroll
        for (int q = 0; q < 4; ++q) { const int m = m0 + q * NGW; if (m < M) { const GAS f32x4* xr = (const GAS f32x4*)(P.x + (size_t)m * DM) + F.lane;
#pragma unroll
            for (int j = 0; j < 4; ++j) v[q][j] = xr[64 * j]; } }
#pragma unroll
        for (int q = 0; q < 4; ++q) { const int m = m0 + q * NGW; if (m < M) { float s = 0.f;
#pragma unroll
            for (int j = 0; j < 4; ++j) s += (v[q][j].x * v[q][j].x + v[q][j].y * v[q][j].y) + (v[q][j].z * v[q][j].z + v[q][j].w * v[q][j].w);
            const float rstd = rsqrtf(wave_sum(s) * (1.f / DM) + EPS);
            GAS unsigned long long* o8 = (GAS unsigned long long*)(ws + WS_HB + (size_t)m * DM * 2) + F.lane;
#pragma unroll
            for (int j = 0; j < 4; ++j) o8[64 * j] = (unsigned long long)pk2(v[q][j].x * rstd, v[q][j].y * rstd) | ((unsigned long long)pk2(v[q][j].z * rstd, v[q][j].w * rstd) << 32); } }
    }
    { TrItem tc, tn; f32x4 vc[8], vn[8]; float gc[8], gn[8];
      int it = gw; bool have = tr_decode(P, ws, it, tc);
      if (have) tr_load(tc, F.lane, vc, gc);
      while (have) {
          const bool more = tr_decode(P, ws, it + NGW, tn);
          if (more) tr_load(tn, F.lane, vn, gn);
          tr_store(tc, F.lane, vc, gc, scr);
          if (more) { tc = tn;
#pragma unroll
              for (int i = 0; i < 8; ++i) { vc[i] = vn[i]; gc[i] = gn[i]; } }
          have = more; it += NGW;
      } }
    const v4u zero4 = {0u, 0u, 0u, 0u};
    for (int i = gt; i < 12288; i += NGT) *(GAS v4u*)(ws + WS_W1 + (size_t)DIN * DM * 2 + (size_t)i * 16) = zero4;
    for (int i = gt; i < 16384; i += NGT) *(GAS v4u*)(ws + WS_WUKV + (size_t)(i >> 4) * 512 + 256 + (size_t)(i & 15) * 16) = zero4;
    for (int i = gt; i < SEQ * 16; i += NGT) {
        const int pos = i >> 4, j = i & 15;
        constexpr float INVF[16] = {1.0f, 0.5623413324356079f, 0.3162277638912201f, 0.17782793939113617f, 0.10000000149011612f, 0.05623413249850273f, 0.03162277489900589f, 0.017782794311642647f,
                                    0.009999999776482582f, 0.005623413249850273f, 0.003162277629598975f, 0.0017782794311642647f, 0.0010000000474974513f, 0.000562341301701963f, 0.0003162277571391314f, 0.00017782794020604342f};
        const float invf = INVF[j];
        const float ang = (float)pos * invf;
        const double t = (double)ang * 0.15915494309189533577;
        const float fr = (float)(t - __builtin_floor(t));
        ((GAS float*)(ws + WS_COS))[i] = __builtin_amdgcn_cosf(fr); ((GAS float*)(ws + WS_SIN))[i] = __builtin_amdgcn_sinf(fr);
    }
    for (int i0 = gt; i0 < M * PLE / 8; i0 += 4 * NGT) {
        f32x4 a[4], b[4];
#pragma unroll
        for (int q = 0; q < 4; ++q) { const int i = i0 + q * NGT; if (i < M * PLE / 8) { a[q] = *(const GAS f32x4*)(P.p + (size_t)i * 8); b[q] = *(const GAS f32x4*)(P.p + (size_t)i * 8 + 4); } }
#pragma unroll
        for (int q = 0; q < 4; ++q) { const int i = i0 + q * NGT; if (i < M * PLE / 8) {
            v4u o; o.x = pk2(a[q][0], a[q][1]); o.y = pk2(a[q][2], a[q][3]); o.z = pk2(b[q][0], b[q][1]); o.w = pk2(b[q][2], b[q][3]);
            *(GAS v4u*)(ws + WS_PB + (size_t)i * 16) = o; } }
    }
}

__device__ __forceinline__ float bf_lo(unsigned w) { return __uint_as_float(w << 16); }
__device__ __forceinline__ float bf_hi(unsigned w) { return __uint_as_float(w & 0xffff0000u); }

__device__ __forceinline__ void p2_mixer_prep(Frame& F, const Ptrs& P) {
    unsigned char* ws = P.ws;
    const int gw = F.vcu * NWAVES + F.wave, NGW = F.G * NWAVES, lane = F.lane;
    const bf16* Z = (const bf16*)(ws + WS_Z);
    constexpr int NB = 4;
    float cw0[8], cw1[8], cw2[8];
#pragma unroll
    for (int j = 0; j < 8; ++j) { cw0[j] = P.conv_w[8 * lane + j]; cw1[j] = P.conv_w[CONVW + 8 * lane + j]; cw2[j] = P.conv_w[2 * CONVW + 8 * lane + j]; }
    const float* cosT = (const float*)(ws + WS_COS); const float* sinT = (const float*)(ws + WS_SIN);
    const int l32 = lane & 31, i16 = lane & 15;
    for (int blk = gw; blk < M / NB; blk += NGW) {
        const int m0 = blk * NB, t0 = m0 & (SEQ - 1);
        const bf16* zr = Z + (size_t)m0 * DINP;
        const v4u zero4 = {0u, 0u, 0u, 0u};
        v4u xc[NB + 2], cg[NB + 2], bgv[NB]; unsigned long long ql[NB]; unsigned kvl[NB]; unsigned krv[NB]; float cs[NB], sn[NB];
#pragma unroll
        for (int r = 0; r < NB + 2; ++r) { const int t = t0 + r - 1; const bool ok = (t >= 0) && (t < SEQ);
            xc[r] = ok ? *(const GAS v4u*)(zr + (r - 1) * DINP + 8 * lane) : zero4; cg[r] = ok ? *(const GAS v4u*)(zr + (r - 1) * DINP + 1024 + 8 * lane) : zero4; }
#pragma unroll
        for (int r = 0; r < NB; ++r) { const bf16* z1 = zr + r * DINP;
            bgv[r] = *(const GAS v4u*)(z1 + 512 + 8 * lane); ql[r] = *(const GAS unsigned long long*)(z1 + 1536 + 4 * lane); kvl[r] = *(const GAS unsigned*)(z1 + 1792 + 2 * lane);
            krv[r] = z1[1920 + l32]; cs[r] = cosT[(t0 + r) * 16 + i16]; sn[r] = sinT[(t0 + r) * 16 + i16]; }
        float u[NB + 2][8];
#pragma unroll
        for (int r = 0; r < NB + 2; ++r)
#pragma unroll
            for (int q = 0; q < 4; ++q) { u[r][2 * q] = bf_lo(xc[r][q]) * bf_lo(cg[r][q]); u[r][2 * q + 1] = bf_hi(xc[r][q]) * bf_hi(cg[r][q]); }
#pragma unroll
        for (int r = 0; r < NB; ++r) { v4u yo;
#pragma unroll
            for (int q = 0; q < 4; ++q) {
                const float yl = bf_lo(bgv[r][q]) * (cw0[2 * q] * u[r][2 * q] + cw1[2 * q] * u[r + 1][2 * q] + cw2[2 * q] * u[r + 2][2 * q]);
                const float yh = bf_hi(bgv[r][q]) * (cw0[2 * q + 1] * u[r][2 * q + 1] + cw1[2 * q + 1] * u[r + 1][2 * q + 1] + cw2[2 * q + 1] * u[r + 2][2 * q + 1]);
                yo[q] = pk2(yl, yh); }
            *(GAS v4u*)(ws + WS_HB + ((size_t)(m0 + r) * DM + 8 * lane) * 2) = yo; }
        float sq[NB], sk[NB];
#pragma unroll
        for (int r = 0; r < NB; ++r) { const float a = bf_lo((unsigned)ql[r]), b = bf_hi((unsigned)ql[r]), c = bf_lo((unsigned)(ql[r] >> 32)), d = bf_hi((unsigned)(ql[r] >> 32));
            sq[r] = (a * a + b * b) + (c * c + d * d); const float e = bf_lo(kvl[r]), f = bf_hi(kvl[r]); sk[r] = e * e + f * f; }
#pragma unroll
        for (int o = 1; o < 64; o <<= 1) {
#pragma unroll
            for (int r = 0; r < NB; ++r) { sq[r] += __shfl_xor(sq[r], o); sk[r] += __shfl_xor(sk[r], o); } }
#pragma unroll
        for (int r = 0; r < NB; ++r) { const size_t m = (size_t)(m0 + r);
            const float rq = rsqrtf(sq[r] * (1.f / QLORA) + EPS), rk = rsqrtf(sk[r] * (1.f / KVLORA) + EPS);
            const float a = bf_lo((unsigned)ql[r]), b = bf_hi((unsigned)ql[r]), c = bf_lo((unsigned)(ql[r] >> 32)), d = bf_hi((unsigned)(ql[r] >> 32));
            *(GAS unsigned long long*)(ws + WS_QN + (m * 256 + 4 * lane) * 2) = (unsigned long long)pk2(a * rq, b * rq) | ((unsigned long long)pk2(c * rq, d * rq) << 32);
            *(GAS unsigned*)(ws + WS_KVN + (m * 256 + 2 * lane) * 2) = pk2(bf_lo(kvl[r]) * rk, bf_hi(kvl[r]) * rk);
            *(GAS unsigned*)(ws + WS_KVN + (m * 256 + 128 + 2 * lane) * 2) = 0u;
            const float xv = __uint_as_float(krv[r] << 16), pv = __shfl_xor(xv, 16);
            const float o = (l32 < 16) ? (xv * cs[r] - pv * sn[r]) : (xv * cs[r] + pv * sn[r]);
            const bf16 ob = (bf16)f2bf(o);
            if (lane < 32) {
#pragma unroll
                for (int h = 0; h < NH; ++h) ((GAS bf16*)(ws + WS_K))[m * LDKK + h * QKD + NOPE + l32] = ob; }
        }
    }
}

__device__ __forceinline__ void p9_final_norm(Frame& F, const Ptrs& P) {
    const int gw = F.vcu * NWAVES + F.wave, NGW = F.G * NWAVES;
    const float* ssq = (const float*)(P.ws + WS_SSQ3);
    f32x4 g[2][2];
#pragma unroll
    for (int j = 0; j < 2; ++j) { g[j][0] = *(const GAS f32x4*)(P.g_final + 512 * j + 8 * F.lane); g[j][1] = *(const GAS f32x4*)(P.g_final + 512 * j + 8 * F.lane + 4); }
    for (int m = gw; m < M; m += NGW) {
        const float rs = pg8::rstd16(ssq, m);
        const bf16* xr = (const bf16*)(P.ws + WS_XB) + (size_t)m * DM + 8 * F.lane; float* orow = P.out + (size_t)m * DM + 8 * F.lane;
#pragma unroll
        for (int j = 0; j < 2; ++j) { const v4u w = *(const GAS v4u*)(xr + 512 * j);
            const f32x4 a = {bf_lo(w.x), bf_hi(w.x), bf_lo(w.y), bf_hi(w.y)}, b = {bf_lo(w.z), bf_hi(w.z), bf_lo(w.w), bf_hi(w.w)};
            *(GAS f32x4*)(orow + 512 * j) = a * rs * g[j][0]; *(GAS f32x4*)(orow + 512 * j + 4) = b * rs * g[j][1]; }
    }
}

struct Args { const float* in[19]; float* out; unsigned char* ws; int ph_lo, ph_hi; };
__global__ void __launch_bounds__(NWAVES * 64, 2) mk_fwd(Args args) {
    extern __shared__ __attribute__((aligned(16))) unsigned char lds[];
    Frame F;
    F.lds = (LAS unsigned char*)lds;
    F.tid = threadIdx.x; F.lane = F.tid & 63; F.wave = __builtin_amdgcn_readfirstlane(F.tid >> 6);
    F.G = gridDim.x; { const int bx = blockIdx.x; F.vcu = (F.G % 8 == 0) ? (bx % 8) * (F.G / 8) + bx / 8 : bx; }
    Ptrs P;
    P.x = args.in[0]; P.p = args.in[1]; P.g_mix = args.in[2]; P.w_in = args.in[3]; P.conv_w = args.in[4]; P.g_q = args.in[5]; P.w_uq = args.in[6]; P.g_kv = args.in[7];
    P.w_ukv = args.in[8]; P.w_o = args.in[9]; P.g_ffn = args.in[10]; P.w_up = args.in[11]; P.fcw = args.in[12]; P.fcb = args.in[13]; P.w_down = args.in[14];
    P.g_ple = args.in[15]; P.w_gate = args.in[16]; P.w_proj = args.in[17]; P.g_final = args.in[18]; P.out = args.out; P.ws = args.ws;
    unsigned char* ws = args.ws;
    volatile LAS unsigned* MISC = (volatile LAS unsigned*)(F.lds + MISC_OFF);
    if (F.tid < 128) MISC[F.tid] = 0u;
    __syncthreads();
    XcdBarrier bar; bar.bar = (unsigned*)(ws + WS_CTL) + CW_BAR; bar.x = 0; bar.st = nullptr;
    if (N_LAUNCHES == 1) bar = xcd_barrier_post((unsigned*)(ws + WS_CTL) + CW_BAR, MISC + 8);
    const int lo = args.ph_lo, hi = args.ph_hi;
#ifndef PROBE_A
#define PROBE_A -1
#define PROBE_B -1
#endif
#if PROBE_A >= 0
    unsigned long long tsa = 0;
#define STAMP_BEGIN(k) do { if ((k) == PROBE_A && blockIdx.x == 0 && F.tid == 0) tsa = __builtin_amdgcn_s_memrealtime(); } while (0)
#define STAMP(k) do { if ((k) == PROBE_B) { if (blockIdx.x == 0 && F.tid == 0) { const unsigned long long tb = __builtin_amdgcn_s_memrealtime(), dt = tb - tsa; \
        while (__builtin_amdgcn_s_memrealtime() - tb < dt) __builtin_amdgcn_s_sleep(8); } xcd_barrier(bar); } } while (0)
#else
#define STAMP_BEGIN(k) do {} while (0)
#define STAMP(k) do {} while (0)
#endif
#ifndef PHMASK
#define PHMASK 0x3ff
#endif
#define IN(k) (((PHMASK >> (k)) & 1) && lo <= (k) && (k) < hi)
#ifndef DUPMASK
#define DUPMASK 0
#endif
#define DUP(k) ((DUPMASK >> (k)) & 1)
#define SEAM(k) do { if (IN(k) && IN((k) + 1)) xcd_barrier(bar); STAMP(k); } while (0)

    STAMP_BEGIN(0);
    if (IN(0)) { p0_prologue(F, P); if (DUP(0)) p0_prologue(F, P); } SEAM(0);

    STAMP_BEGIN(1);
    if (IN(1)) {
        pg8::Gemm g{(const pg8::bf16_t*)(ws + WS_HB), (const pg8::bf16_t*)(ws + WS_W1), M, DINP, DM}; pg8::DupOrder<pg8::StaticOrder, DUP(1)> S; S.init(M, DINP, F.G, (int)blockIdx.x);
        pg8::EpiStoreBf16 E{(pg8::bf16_t*)(ws + WS_Z), DINP};
        pg8::gemm_phase<pg8::EpiStoreBf16, pg8::DupOrder<pg8::StaticOrder, DUP(1)>, true, true>(F.lds + RING_OFF, g, S, E);
    } SEAM(1);

    STAMP_BEGIN(2);
    if (IN(2)) { p2_mixer_prep(F, P); if (DUP(2)) p2_mixer_prep(F, P); } SEAM(2);

    STAMP_BEGIN(3);
    if (IN(3)) {
        pg8::Gemm g{(const pg8::bf16_t*)(ws + WS_QN), (const pg8::bf16_t*)(ws + WS_WUQ), 3 * M, 2816, 256}; pg8::DupOrder<pg8::P3Order, DUP(3)> S; S.G = F.G; S.c = (int)blockIdx.x;
        pg8::EpiP3 E{(pg8::bf16_t*)(ws + WS_Q), (pg8::bf16_t*)(ws + WS_K), (pg8::bf16_t*)(ws + WS_V), (pg8::bf16_t*)(ws + WS_PP), (const float*)(ws + WS_COS), (const float*)(ws + WS_SIN), QSCALE};
        pg8::gemm_phase<pg8::EpiP3, pg8::DupOrder<pg8::P3Order, DUP(3)>, true, true>(F.lds + RING_OFF, g, S, E);
    } SEAM(3);

    STAMP_BEGIN(4);
    if (IN(4)) {
        static_assert(attn::LDS_BYTES <= RING_BYTES, "attention LDS");
        const int nunits = BATCH * NH * (SEQ / 256);
        for (int i = 0; ; ++i) {
            const int ii = DUP(4) ? (i >> 1) : i;
            const int uidx = (F.G == 256) ? (((F.vcu >> 5) * 2 + ii) * 32 + (F.vcu & 31)) : (ii * F.G + F.vcu);
            if ((F.G == 256 && ii >= 2) || uidx >= nunits) break;
            const int pair = uidx >> 5, qb = uidx & 31, b = pair >> 3, h = pair & 7;
            const size_t row0 = (size_t)b * SEQ;
            attn::attn_unit((const attn::bf16_t*)(ws + WS_Q) + (row0 + qb * 256) * LDQ + h * QKD, (const attn::bf16_t*)(ws + WS_K) + row0 * LDKK + h * QKD,
                            (const attn::bf16_t*)(ws + WS_V) + row0 * LDV + h * VH, (attn::bf16_t*)(ws + WS_HB) + (row0 + qb * 256) * DM + CONVW + h * VH, SEQ, (__attribute__((address_space(3))) char*)(F.lds + RING_OFF));
        }
    } SEAM(4);

    STAMP_BEGIN(5);
    if (IN(5)) {
        pg8::Gemm g{(const pg8::bf16_t*)(ws + WS_HB), (const pg8::bf16_t*)(ws + WS_WO), M, DM, DM}; pg8::DupOrder<pg8::StaticOrder, DUP(5)> S; S.init(M, DM, F.G, (int)blockIdx.x);
        pg8::EpiRes<false> E{P.x, nullptr, (pg8::bf16_t*)(ws + WS_XB), (float*)(ws + WS_SSQ1)};
        pg8::gemm_phase<pg8::EpiRes<false>, pg8::DupOrder<pg8::StaticOrder, DUP(5)>, true, true>(F.lds + RING_OFF, g, S, E);
    } SEAM(5);

    STAMP_BEGIN(6);
    if (IN(6)) {
        pg8::Gemm g{(const pg8::bf16_t*)(ws + WS_XB), (const pg8::bf16_t*)(ws + WS_WUP), M, NUP, DM}; pg8::DupOrder<pg8::UpOrder, DUP(6)> S; S.init_up(F.G, (int)blockIdx.x);
        PG8_LAS float* rstd_l = (PG8_LAS float*)(F.lds + RSTD_OFF);
        { pg8::Unit u;
          for (int i = F.tid >> 8; i < 6 && S.pg8::UpOrder::next(i, u); i += 2) rstd_l[i * 256 + (F.tid & 255)] = pg8::rstd16((const float*)(ws + WS_SSQ1), u.arow + (F.tid & 255));
          __syncthreads(); }
        pg8::EpiUp E{(pg8::bf16_t*)(ws + WS_Z), P.fcw, P.fcb, (PG8_LAS float*)(F.lds + HALO_OFF), rstd_l};
        pg8::gemm_phase<pg8::EpiUp, pg8::DupOrder<pg8::UpOrder, DUP(6)>, true, true>(F.lds + RING_OFF, g, S, E);
    } SEAM(6);

    STAMP_BEGIN(7);
    if (IN(7)) {
        pg8::Gemm g{(const pg8::bf16_t*)(ws + WS_Z), (const pg8::bf16_t*)(ws + WS_WDN), M, DM, DFF}; pg8::DupOrder<pg8::StaticOrder, DUP(7)> S; S.init(M, DM, F.G, (int)blockIdx.x);
        pg8::EpiRes<true> E{nullptr, (const pg8::bf16_t*)(ws + WS_XB), (pg8::bf16_t*)(ws + WS_HB), (float*)(ws + WS_SSQ2)};
        pg8::gemm_phase<pg8::EpiRes<true>, pg8::DupOrder<pg8::StaticOrder, DUP(7)>, true, true>(F.lds + RING_OFF, g, S, E);
    } SEAM(7);

    STAMP_BEGIN(8);
    if (IN(8)) {
        pg8::Gemm g{(const pg8::bf16_t*)(ws + WS_HB), (const pg8::bf16_t*)(ws + WS_WG), M, DM, DM}; pg8::DupOrder<pg8::StaticOrder, DUP(8)> S; S.init(M, DM, F.G, (int)blockIdx.x);
        pg8::EpiGate E{(const pg8::bf16_t*)(ws + WS_HB), (pg8::bf16_t*)(ws + WS_XB), (const pg8::bf16_t*)(ws + WS_PP), (const float*)(ws + WS_SSQ2), (float*)(ws + WS_SSQ3)};
        pg8::gemm_phase<pg8::EpiGate, pg8::DupOrder<pg8::StaticOrder, DUP(8)>, true, true>(F.lds + RING_OFF, g, S, E);
    } SEAM(8);

    STAMP_BEGIN(9);
    if (IN(9)) { p9_final_norm(F, P); if (DUP(9)) p9_final_norm(F, P); }
    STAMP(9);
#undef IN
#undef SEAM
}

extern "C" void kernel_launch(void* const* d_in, const int* in_sizes, int n_in, void* d_out, int out_size, void* d_ws, size_t ws_size, hipStream_t stream) {
    static int grid = 0;
    if (grid == 0) {
        if (n_in != 19 || in_sizes[0] != M * DM || out_size != M * DM || ws_size < WS_END) { fprintf(stderr, "kernel_launch: unexpected shapes (n_in %d, in0 %d, out %d, ws %zu)\n", n_in, n_in > 0 ? in_sizes[0] : -1, out_size, ws_size); grid = -1; return; }
        int dev = 0, cus = 0, per_cu = 0;
        if (hipGetDevice(&dev) != hipSuccess || hipDeviceGetAttribute(&cus, hipDeviceAttributeMultiprocessorCount, dev) != hipSuccess) { grid = -1; return; }
        if (hipFuncSetAttribute((const void*)mk_fwd, hipFuncAttributeMaxDynamicSharedMemorySize, LDS_BYTES) != hipSuccess) { fprintf(stderr, "kernel_launch: hipFuncSetAttribute failed\n"); grid = -1; return; }
        if (hipOccupancyMaxActiveBlocksPerMultiprocessor(&per_cu, (const void*)mk_fwd, NWAVES * 64, LDS_BYTES) != hipSuccess || per_cu < 1) { fprintf(stderr, "kernel_launch: occupancy query says %d blocks per CU\n", per_cu); per_cu = 1; }
        (void)hipGetLastError();
        grid = cus;
    }
    if (grid < 0) return;
    if (hipMemsetAsync((char*)d_ws + WS_CTL, 0, CTL_ZERO_BYTES, stream) != hipSuccess) { fprintf(stderr, "kernel_launch: memset failed\n"); return; }
    Args a{};
    for (int i = 0; i < 19; ++i) a.in[i] = (const float*)d_in[i];
    a.out = (float*)d_out; a.ws = (unsigned char*)d_ws;
    if (N_LAUNCHES == 1) {
        a.ph_lo = 0; a.ph_hi = N_PHASES;
#if MK_COOP
        void* kargs[] = {&a};
        hipError_t e = hipLaunchCooperativeKernel((const void*)mk_fwd, dim3(grid), dim3(NWAVES * 64), kargs, LDS_BYTES, stream);
        if (e != hipSuccess) fprintf(stderr, "kernel_launch: cooperative launch failed: %s (grid %d)\n", hipGetErrorString(e), grid);
#else
        hipLaunchKernelGGL(mk_fwd, dim3(grid), dim3(NWAVES * 64), LDS_BYTES, stream, a);
        const hipError_t e = hipPeekAtLastError();
        if (e != hipSuccess) fprintf(stderr, "kernel_launch: launch failed: %s\n", hipGetErrorName(e));
#endif
    } else {
        for (int li = 0; li < N_PHASES; ++li) {
            a.ph_lo = li; a.ph_hi = li + 1;
            hipLaunchKernelGGL(mk_fwd, dim3(grid), dim3(NWAVES * 64), LDS_BYTES, stream, a);
        }
        const hipError_t le = hipPeekAtLastError();
        if (le != hipSuccess) fprintf(stderr, "kernel_launch: launch failed: %s\n", hipGetErrorName(le));
    }
}
```

```cpp
#include <hip/hip_runtime.h>
#include <hip/hip_bf16.h>
#include <cstdio>
#include <cstdint>
#include <cmath>

constexpr int BATCH = 2, SEQ = 8192, DM = 1024, M = BATCH * SEQ;
constexpr int PLE = 256, CONVW = 512, NH = 8, QLORA = 256, KVLORA = 128, NOPE = 64, ROPE = 32, VH = 64, QKD = 96;
constexpr int DIN = 1952, DINP = 2048, DFF = 2816, NUP = 2 * DFF;
constexpr int LDQ = NH * QKD, LDKK = NH * QKD, LDV = NH * VH;
constexpr float EPS = 1e-6f;
constexpr float QSCALE = 0.10206207261596575f * 1.4426950408889634f;
namespace pg8 {
#define PG8_LAS __attribute__((address_space(3)))
typedef unsigned short bf16_t;
typedef short bf16x8 __attribute__((ext_vector_type(8)));
typedef float f32x4 __attribute__((ext_vector_type(4)));
typedef unsigned u32x4 __attribute__((ext_vector_type(4)));
constexpr int BM = 256, BK = 64, HALF = 128, HTB = HALF * BK * 2  , STAGE_BYTES = 8 * HTB, NXCD = 8, WGM = 8;

__host__ __device__ __forceinline__ int lds_byte(int r, int c) { const int st = (r >> 4) * 2 + (c >> 5), rr = r & 15, cc = c & 31, ob = rr * 64 + cc * 2; return st * 1024 + (ob ^ (((ob >> 9) & 1) << 5)); }
__host__ __device__ __forceinline__ void stage_rc(int b, int& R, int& C) { const int st = b / 1024, sb = b % 1024, swz = sb ^ (((sb >> 9) & 1) << 5); R = (st >> 1) * 16 + swz / 64; C = (st & 1) * 32 + (swz % 64) / 2; }
__host__ __device__ __forceinline__ int perm32(int rho) { const int n = rho >> 4, i = rho & 15; return 8 * (i >> 2) + 4 * n + (i & 3); }

struct Unit { int pm, pn, arow, ord; };
struct Gemm { const bf16_t* A; const bf16_t* Bt; int M, N, K; };

struct StaticOrder {
    int nM, nN, nwg, G, c;
    __host__ __device__ void init(int M, int N, int G_, int c_) { nM = M / BM; nN = N / BM; nwg = nM * nN; G = G_; c = c_; }
    __host__ __device__ bool next(int i, Unit& u) const {
        const long L = (long)i * G + c; if (L >= nwg) return false;
        int wgid = (int)L; { const int q = nwg / NXCD, r = nwg % NXCD, xcd = wgid % NXCD, off = wgid / NXCD; wgid = (xcd < r ? xcd * (q + 1) : r * (q + 1) + (xcd - r) * q) + off; }
        const int nig = WGM * nN, gid = wgid / nig, fm = gid * WGM, gsz = (nM - fm) < WGM ? (nM - fm) : WGM;
        u.pm = fm + ((wgid % nig) % gsz); u.pn = (wgid % nig) / gsz; u.arow = u.pm * BM; u.ord = i; return true;
    }
    __device__ __forceinline__ void a_ready(const Unit&) const {}
    __device__ __forceinline__ void done(const Unit&) const {}
};

__device__ __forceinline__ unsigned cvt_pk_bf16(float lo, float hi) { unsigned r; asm volatile("v_cvt_pk_bf16_f32 %0, %1, %2" : "=v"(r) : "v"(lo), "v"(hi)); return r; }
typedef float f32x2 __attribute__((ext_vector_type(2)));
typedef unsigned u32x2 __attribute__((ext_vector_type(2)));
__device__ __forceinline__ u32x2 pack4(const f32x4 v) { u32x2 w; w.x = cvt_pk_bf16(v[0], v[1]); w.y = cvt_pk_bf16(v[2], v[3]); return w; }
__device__ __forceinline__ u32x4 pack8(const f32x4 a, const f32x4 b) { u32x4 w; w.x = cvt_pk_bf16(a[0], a[1]); w.y = cvt_pk_bf16(a[2], a[3]); w.z = cvt_pk_bf16(b[0], b[1]); w.w = cvt_pk_bf16(b[2], b[3]); return w; }
__device__ __forceinline__ f32x4 unpack4(const u32x2 w) { f32x4 v; v[0] = __uint_as_float(w.x << 16); v[1] = __uint_as_float(w.x & 0xffff0000u); v[2] = __uint_as_float(w.y << 16); v[3] = __uint_as_float(w.y & 0xffff0000u); return v; }
__device__ __forceinline__ float rstd16(const float* ssqp, int row) {
    const f32x4* p = (const f32x4*)(ssqp + (size_t)row * 16); const f32x4 a = p[0], b = p[1], c = p[2], d = p[3];
    const float s = ((a[0] + a[1]) + (a[2] + a[3])) + ((b[0] + b[1]) + (b[2] + b[3])) + ((c[0] + c[1]) + (c[2] + c[3])) + ((d[0] + d[1]) + (d[2] + d[3]));
    return rsqrtf(s * (1.0f / 1024.0f) + 1e-6f);
}


struct EpiStoreBf16 {
    static constexpr bool PERM = true, AFTER_DRAIN = false;
    bf16_t* O; int ldc;
    __device__ __forceinline__ void operator()(f32x4 (&acc)[2][2][4][2], const Unit& u, int wr, int wc, int fr, int fq, int lane) const {
        const int row0 = u.pm * BM + wr * 64 + fr, col0 = u.pn * BM + wc * 32 + 8 * fq;
#pragma unroll
        for (int ai = 0; ai < 2; ++ai)
#pragma unroll
            for (int m = 0; m < 4; ++m) { bf16_t* rowp = O + (size_t)(row0 + ai * HALF + m * 16) * ldc + col0;
#pragma unroll
                for (int bj = 0; bj < 2; ++bj) *(u32x4*)(rowp + bj * HALF) = pack8(acc[ai][bj][m][0], acc[ai][bj][m][1]); }
    }
};

struct EpiP3 {
    static constexpr bool PERM = true, AFTER_DRAIN = false;
    bf16_t* Q; bf16_t* Kb; bf16_t* Vb; bf16_t* PP; const float* cosT; const float* sinT; float scale;
    __device__ __forceinline__ void operator()(f32x4 (&acc)[2][2][4][2], const Unit& u, int wr, int wc, int fr, int fq, int lane) const {
        const int row0 = u.pm * BM + wr * 64 + fr;
        if (u.pn < 3) {
#pragma unroll
            for (int bj = 0; bj < 2; ++bj) {
                const int gc0 = u.pn * BM + bj * HALF + wc * 32;
                const bool rope = (gc0 % 96) == 64;
#pragma unroll
                for (int ai = 0; ai < 2; ++ai)
#pragma unroll
                    for (int m = 0; m < 4; ++m) {
                        const int row = row0 + ai * HALF + m * 16, pos = row & (SEQ - 1);
                        f32x4 v0 = acc[ai][bj][m][0], v1 = acc[ai][bj][m][1];
                        if (rope) { const float* cp = cosT + pos * 16 + 8 * (fq & 1); const float* sp = sinT + pos * 16 + 8 * (fq & 1);
                            const f32x4 c0 = *(const f32x4*)cp, c1 = *(const f32x4*)(cp + 4), s0 = *(const f32x4*)sp, s1 = *(const f32x4*)(sp + 4);
                            f32x4 p0, p1;
#pragma unroll
                            for (int j = 0; j < 4; ++j) { p0[j] = __shfl_xor(v0[j], 32); p1[j] = __shfl_xor(v1[j], 32); }
                            const float sg = (fq < 2) ? -1.0f : 1.0f;
                            v0 = v0 * c0 + p0 * s0 * sg; v1 = v1 * c1 + p1 * s1 * sg; }
                        *(u32x4*)(Q + (size_t)row * 768 + gc0 + 8 * fq) = pack8(v0 * scale, v1 * scale);
                        asm volatile("" ::: "memory");
                    }
            }
        } else if (u.pn < 7) {
#pragma unroll
            for (int bj = 0; bj < 2; ++bj) {
                const int head = 2 * (u.pn - 3) + bj, within = wc * 32 + 8 * fq;
                bf16_t* base = (wc < 2) ? (Kb + head * 96 + within) : (Vb + head * 64 + (within - 64));
                const int ld = (wc < 2) ? 768 : 512;
#pragma unroll
                for (int ai = 0; ai < 2; ++ai)
#pragma unroll
                    for (int m = 0; m < 4; ++m) { const int row = row0 + ai * HALF + m * 16;
                        *(u32x4*)(base + (size_t)row * ld) = pack8(acc[ai][bj][m][0], acc[ai][bj][m][1]); }
            }
        } else {
            const int col0 = (u.pn - 7) * BM + wc * 32 + 8 * fq;
#pragma unroll
            for (int ai = 0; ai < 2; ++ai)
#pragma unroll
                for (int m = 0; m < 4; ++m) { bf16_t* rowp = PP + (size_t)(row0 + ai * HALF + m * 16) * 1024 + col0;
#pragma unroll
                    for (int bj = 0; bj < 2; ++bj) *(u32x4*)(rowp + bj * HALF) = pack8(acc[ai][bj][m][0], acc[ai][bj][m][1]); }
        }
    }
};
struct P3Order {
    int G, c;
    __host__ __device__ bool next(int i, Unit& u) const {
        const int L = i * G + c; if (L >= 11 * 64) return false;
        u.pn = L >> 6; u.pm = L & 63; u.ord = i;
        const int which = (u.pn < 3) ? 0 : (u.pn < 7 ? 1 : 2);
        u.arow = which * M + u.pm * BM; return true;
    }
    __device__ __forceinline__ void a_ready(const Unit&) const {}
    __device__ __forceinline__ void done(const Unit&) const {}
};

template <bool RESB> struct EpiRes {
    static constexpr bool PERM = false, AFTER_DRAIN = false;
    const float* resf; const bf16_t* resb; bf16_t* xb; float* ssqp;
    __device__ __forceinline__ void operator()(f32x4 (&acc)[2][2][4][2], const Unit& u, int wr, int wc, int fr, int fq, int lane) const {
        const int col0 = u.pn * BM + wc * 32 + 4 * fq;
#pragma unroll
        for (int ai = 0; ai < 2; ++ai)
#pragma unroll
            for (int m = 0; m < 4; ++m) {
                const int row = u.pm * BM + ai * HALF + wr * 64 + m * 16 + fr; const size_t off = (size_t)row * 1024 + col0; float ss = 0.f;
#pragma unroll
                for (int bj = 0; bj < 2; ++bj)
#pragma unroll
                    for (int n = 0; n < 2; ++n) { const size_t o = off + bj * HALF + n * 16;
                        const f32x4 r = RESB ? unpack4(*(const u32x2*)(resb + o)) : *(const f32x4*)(resf + o); const f32x4 v = r + acc[ai][bj][m][n];
                        *(u32x2*)(xb + o) = pack4(v); ss += (v[0] * v[0] + v[1] * v[1]) + (v[2] * v[2] + v[3] * v[3]); }
                ss += __shfl_xor(ss, 16); ss += __shfl_xor(ss, 32);
                if (fq == 0) ssqp[(size_t)row * 16 + u.pn * 4 + wc] = ss;
                asm volatile("" ::: "memory");
            }
    }
};

struct EpiGate {
    static constexpr bool PERM = false, AFTER_DRAIN = false;
    const bf16_t* x2; bf16_t* out; const bf16_t* pp; const float* ssq2p; float* ssq3p;
    __device__ __forceinline__ void operator()(f32x4 (&acc)[2][2][4][2], const Unit& u, int wr, int wc, int fr, int fq, int lane) const {
        const int col0 = u.pn * BM + wc * 32 + 4 * fq;
#pragma unroll
        for (int ai = 0; ai < 2; ++ai)
#pragma unroll
            for (int m = 0; m < 4; ++m) {
                const int row = u.pm * BM + ai * HALF + wr * 64 + m * 16 + fr; const size_t off = (size_t)row * 1024 + col0; float ss = 0.f;
                const float rs = rstd16(ssq2p, row);
#pragma unroll
                for (int bj = 0; bj < 2; ++bj)
#pragma unroll
                    for (int n = 0; n < 2; ++n) { const size_t o = off + bj * HALF + n * 16; const f32x4 a = acc[ai][bj][m][n] * rs; f32x4 g;
#pragma unroll
                        for (int j = 0; j < 4; ++j) g[j] = __builtin_amdgcn_rcpf(1.0f + __expf(-a[j]));
                        const f32x4 v = unpack4(*(const u32x2*)(x2 + o)) + g * unpack4(*(const u32x2*)(pp + o));
                        *(u32x2*)(out + o) = pack4(v); ss += (v[0] * v[0] + v[1] * v[1]) + (v[2] * v[2] + v[3] * v[3]); }
                ss += __shfl_xor(ss, 16); ss += __shfl_xor(ss, 32);
                if (fq == 0) ssq3p[(size_t)row * 16 + u.pn * 4 + wc] = ss;
                asm volatile("" ::: "memory");
            }
    }
};

__device__ __forceinline__ float conv_taps(float a, float v, float p, float n, float w0, float w2) {
    asm("s_nop 1\n\t"
        "v_fmac_f32_dpp %0, %1, %4 row_shr:1 row_mask:0xf bank_mask:0xf bound_ctrl:1\n\t"
        "v_fmac_f32_dpp %0, %2, %4 row_shl:15 row_mask:0xf bank_mask:0xf bound_ctrl:1\n\t"
        "v_fmac_f32_dpp %0, %1, %5 row_shl:1 row_mask:0xf bank_mask:0xf bound_ctrl:1\n\t"
        "v_fmac_f32_dpp %0, %3, %5 row_shr:15 row_mask:0xf bank_mask:0xf bound_ctrl:1"
        : "+v"(a) : "v"(v), "v"(p), "v"(n), "v"(w0), "v"(w2));
    return a;
}
__device__ __forceinline__ float dpp_shr1(float v)  { return __builtin_bit_cast(float, __builtin_amdgcn_update_dpp(0, __builtin_bit_cast(int, v), 0x111, 0xf, 0xf, true)); }
__device__ __forceinline__ float dpp_shl1(float v)  { return __builtin_bit_cast(float, __builtin_amdgcn_update_dpp(0, __builtin_bit_cast(int, v), 0x101, 0xf, 0xf, true)); }
__device__ __forceinline__ float dpp_shr15(float v) { return __builtin_bit_cast(float, __builtin_amdgcn_update_dpp(0, __builtin_bit_cast(int, v), 0x11F, 0xf, 0xf, true)); }
__device__ __forceinline__ float dpp_shl15(float v) { return __builtin_bit_cast(float, __builtin_amdgcn_update_dpp(0, __builtin_bit_cast(int, v), 0x10F, 0xf, 0xf, true)); }
__device__ __forceinline__ float dpp_ror1(float v) { return __builtin_bit_cast(float, __builtin_amdgcn_update_dpp(0, __builtin_bit_cast(int, v), 0x121, 0xf, 0xf, false)); }
__device__ __forceinline__ float dpp_ror15(float v) { return __builtin_bit_cast(float, __builtin_amdgcn_update_dpp(0, __builtin_bit_cast(int, v), 0x12F, 0xf, 0xf, false)); }
__device__ __forceinline__ f32x4 ror1v(const f32x4 v) { f32x4 r; r[0] = dpp_ror1(v[0]); r[1] = dpp_ror1(v[1]); r[2] = dpp_ror1(v[2]); r[3] = dpp_ror1(v[3]); return r; }
__device__ __forceinline__ f32x4 ror15v(const f32x4 v) { f32x4 r; r[0] = dpp_ror15(v[0]); r[1] = dpp_ror15(v[1]); r[2] = dpp_ror15(v[2]); r[3] = dpp_ror15(v[3]); return r; }
struct EpiUp {
    static constexpr bool PERM = true, AFTER_DRAIN = false;
    bf16_t* H; const float* cw; const float* cb; PG8_LAS float* halo; const PG8_LAS float* rstd;
    __device__ __forceinline__ void operator()(f32x4 (&acc)[2][2][4][2], const Unit& u, int wr, int wc, int fr, int fq, int lane) const {
        const int s = u.arow & (SEQ - 1); const bool first = (s == 0), last = (s + 256 == SEQ);
        const int ch0 = wc * 32 + 8 * fq;
#pragma unroll
        for (int ai = 0; ai < 2; ++ai)
#pragma unroll
            for (int m = 0; m < 4; ++m) { const float rs = rstd[u.ord * 256 + ai * HALF + wr * 64 + m * 16 + fr];
#pragma unroll
                for (int bj = 0; bj < 2; ++bj)
#pragma unroll
                    for (int n = 0; n < 2; ++n) acc[ai][bj][m][n] = acc[ai][bj][m][n] * rs; }
#pragma unroll
        for (int ai = 0; ai < 2; ++ai) { const int seg = 2 * ai + wr;
            if (fr == 0) {
#pragma unroll
                for (int bj = 0; bj < 2; ++bj)
#pragma unroll
                    for (int n = 0; n < 2; ++n) *(PG8_LAS f32x4*)(halo + (seg * 2 + 0) * 256 + bj * HALF + ch0 + 4 * n) = acc[ai][bj][0][n]; }
            if (fr == 15) {
#pragma unroll
                for (int bj = 0; bj < 2; ++bj)
#pragma unroll
                    for (int n = 0; n < 2; ++n) *(PG8_LAS f32x4*)(halo + (seg * 2 + 1) * 256 + bj * HALF + ch0 + 4 * n) = acc[ai][bj][3][n]; }
        }
        asm volatile("s_waitcnt lgkmcnt(0)" ::: "memory"); __builtin_amdgcn_s_barrier(); asm volatile("" ::: "memory");
        const f32x4 z4 = {0.f, 0.f, 0.f, 0.f};
#pragma unroll
        for (int n = 0; n < 2; ++n) {
            const int gch = u.pn * 128 + ch0 + 4 * n;
            const f32x4 wg0 = *(const f32x4*)(cw + gch), wg1 = *(const f32x4*)(cw + NUP + gch), wg2 = *(const f32x4*)(cw + 2 * NUP + gch), bg = *(const f32x4*)(cb + gch);
            const f32x4 wu0 = *(const f32x4*)(cw + DFF + gch), wu1 = *(const f32x4*)(cw + NUP + DFF + gch), wu2 = *(const f32x4*)(cw + 2 * NUP + DFF + gch), bu = *(const f32x4*)(cb + DFF + gch);
#pragma unroll
            for (int ai = 0; ai < 2; ++ai) {
                const int seg = 2 * ai + wr, sup = seg > 0 ? seg - 1 : 0, sdn = seg < 3 ? seg + 1 : 3;
#pragma unroll
                for (int m = 0; m < 4; ++m) {
                    const int r = ai * HALF + wr * 64 + m * 16 + fr;
                    f32x4 pg, pu, ng, nu;
                    if (m == 0) { pg = *(const PG8_LAS f32x4*)(halo + (sup * 2 + 1) * 256 + ch0 + 4 * n); pu = *(const PG8_LAS f32x4*)(halo + (sup * 2 + 1) * 256 + HALF + ch0 + 4 * n);
                        if (first && seg == 0) { pg = z4; pu = z4; } }
                    else { pg = acc[ai][0][m > 0 ? m - 1 : 0][n]; pu = acc[ai][1][m > 0 ? m - 1 : 0][n]; }
                    if (m == 3) { ng = *(const PG8_LAS f32x4*)(halo + (sdn * 2 + 0) * 256 + ch0 + 4 * n); nu = *(const PG8_LAS f32x4*)(halo + (sdn * 2 + 0) * 256 + HALF + ch0 + 4 * n);
                        if (last && seg == 3) { ng = z4; nu = z4; } }
                    else { ng = acc[ai][0][m < 3 ? m + 1 : 3][n]; nu = acc[ai][1][m < 3 ? m + 1 : 3][n]; }
                    const f32x4 vg = acc[ai][0][m][n], vu = acc[ai][1][m][n];
                    f32x4 hv;
#pragma unroll
                    for (int j = 0; j < 4; ++j) {
                        float ag = fmaf(wg1[j], vg[j], bg[j]), au = fmaf(wu1[j], vu[j], bu[j]);
                        ag = conv_taps(ag, vg[j], pg[j], ng[j], wg0[j], wg2[j]); au = conv_taps(au, vu[j], pu[j], nu[j], wu0[j], wu2[j]);
                        hv[j] = ag * __builtin_amdgcn_rcpf(1.0f + __builtin_amdgcn_exp2f(ag * -1.4426950408889634f)) * au; }
                    u32x2 hp = pack4(hv); asm volatile("" : "+v"(hp));
                    if ((r > 0 || first) && (r < 255 || last)) *(u32x2*)(H + (size_t)(u.arow + r) * DFF + u.pn * 128 + ch0 + 4 * n) = hp;
                }
            }
        }
    }
};
struct UpOrder : StaticOrder {
    __host__ __device__ void init_up(int G_, int c_) { nM = 66; nN = 22; nwg = nM * nN; G = G_; c = c_; }
    __host__ __device__ bool next(int i, Unit& u) const {
        if (!StaticOrder::next(i, u)) return false;
        const int b = u.pm / 33, k = u.pm % 33; int st = 254 * k; if (st > SEQ - 256) st = SEQ - 256;
        u.arow = b * SEQ + st; u.ord = i; return true;
    }
};
template <class Base, int D> struct DupOrder : Base {
    __host__ __device__ bool next(int i, Unit& u) const { return Base::next(D ? (i >> 1) : i, u); }
};
template <class Epi, class Sched, bool ALIGN_EPI = false, bool SP2 = false>
__device__ __forceinline__ void gemm_phase(PG8_LAS unsigned char* lds, const Gemm g, const Sched& S, const Epi& E) {
    const int tid = threadIdx.x, wid = __builtin_amdgcn_readfirstlane(tid >> 6), lane = tid & 63, wr = wid >> 2, wc = wid & 3, fr = lane & 15, fq = lane >> 4;
    int K_ = g.K; asm volatile("" : "+s"(K_));
    const int K = K_, nt = K / BK;
    unsigned voffA[2], voffB[2];
#pragma unroll
    for (int i = 0; i < 2; ++i) { int R, C; stage_rc(tid * 16 + i * 8192, R, C); const int Rb = Epi::PERM ? ((R & ~31) + perm32(R & 31)) : R;
        voffA[i] = (unsigned)(R * K + C) * 2u; voffB[i] = (unsigned)(Rb * K + C) * 2u; }
    const size_t kstep = (size_t)(BK * 2);
    const size_t hstep = (size_t)HALF * K * 2;
    const size_t rstep = (size_t)K * 2;
    const size_t tstep = 2 * hstep;
    const unsigned ldsw = (unsigned)wid * 1024u;
    const int aoff = lds_byte(wr * 64 + fr, fq * 8), boff = lds_byte(wc * 32 + fr, fq * 8);
#define PG8_SA(b, h) (((b) * 2 + (h)) * HTB)
#define PG8_SB(b, h) ((4 + (b) * 2 + (h)) * HTB)
#define PG8_STAGE(bufoff, gbase, voff) do { _Pragma("unroll") for (int _i = 0; _i < 2; ++_i) \
        __builtin_amdgcn_global_load_lds((const unsigned*)((const char*)(gbase) + (voff)[_i]), (PG8_LAS unsigned*)(lds + (bufoff) + ldsw + _i * 8192), 16, 0, 0); } while (0)
#define PG8_LDA(dst, b, h) do { _Pragma("unroll") for (int m = 0; m < 4; ++m) _Pragma("unroll") for (int k = 0; k < 2; ++k) dst[m][k] = *(const PG8_LAS bf16x8*)(lds + PG8_SA(b, h) + aoff + m * 2048 + k * 1024); } while (0)
#define PG8_LDB(dst, b, h) do { _Pragma("unroll") for (int n = 0; n < 2; ++n) _Pragma("unroll") for (int k = 0; k < 2; ++k) dst[n][k] = *(const PG8_LAS bf16x8*)(lds + PG8_SB(b, h) + boff + n * 2048 + k * 1024); } while (0)
#define PG8_MMA(ai, bj, At, Bt) do { __builtin_amdgcn_s_setprio(1); _Pragma("unroll") for (int m = 0; m < 4; ++m) _Pragma("unroll") for (int n = 0; n < 2; ++n) _Pragma("unroll") for (int k = 0; k < 2; ++k) \
        acc[ai][bj][m][n] = __builtin_amdgcn_mfma_f32_16x16x32_bf16(Bt[n][k], At[m][k], acc[ai][bj][m][n], 0, 0, 0); __builtin_amdgcn_s_setprio(0); } while (0)
#define PG8_WAIT_V(n) asm volatile("s_waitcnt vmcnt(" #n ")" ::: "memory")
#define PG8_WAIT_L(n) asm volatile("s_waitcnt lgkmcnt(" #n ")" ::: "memory")
#define PG8_BAR __builtin_amdgcn_s_barrier()
#define PG8_SCHED __builtin_amdgcn_sched_barrier(0)
    Unit cur, nxt; int ui = 0;
    if (!S.next(0, cur)) return;
    f32x4 acc[2][2][4][2];
#pragma unroll
    for (int a = 0; a < 2; ++a)
#pragma unroll
        for (int b = 0; b < 2; ++b)
#pragma unroll
            for (int m = 0; m < 4; ++m)
#pragma unroll
                for (int n = 0; n < 2; ++n) acc[a][b][m][n] = (f32x4){0.f, 0.f, 0.f, 0.f};
    bf16x8 At[4][2], B0[2][2], B1[2][2];
    const char* cA = (const char*)g.A + (size_t)cur.arow * rstep; const char* cB = (const char*)g.Bt + (size_t)cur.pn * tstep;
    S.a_ready(cur);
    if constexpr (SP2) {
        PG8_STAGE(PG8_SB(0, 0), cB, voffB); PG8_STAGE(PG8_SB(0, 1), cB + hstep, voffB); PG8_STAGE(PG8_SA(0, 0), cA, voffA); PG8_STAGE(PG8_SA(0, 1), cA + hstep, voffA);
        if (wr == 1) PG8_BAR;
        PG8_WAIT_V(2); PG8_BAR;
        PG8_STAGE(PG8_SB(1, 0), cB + kstep, voffB); PG8_STAGE(PG8_SA(1, 0), cA + kstep, voffA); PG8_STAGE(PG8_SB(1, 1), cB + hstep + kstep, voffB);
        PG8_WAIT_V(6); PG8_BAR;
    } else {
        PG8_STAGE(PG8_SB(0, 0), cB, voffB); PG8_STAGE(PG8_SA(0, 0), cA, voffA); PG8_STAGE(PG8_SB(0, 1), cB + hstep, voffB); PG8_STAGE(PG8_SA(0, 1), cA + hstep, voffA);
        if (wr == 1) PG8_BAR;
        PG8_WAIT_V(4); PG8_BAR;
        PG8_STAGE(PG8_SB(1, 0), cB + kstep, voffB); PG8_STAGE(PG8_SA(1, 0), cA + kstep, voffA); PG8_STAGE(PG8_SB(1, 1), cB + hstep + kstep, voffB);
        PG8_WAIT_V(6); PG8_BAR;
    }
    for (;;) {
        const bool has_next = S.next(ui + 1, nxt);
        const char* nA = has_next ? (const char*)g.A + (size_t)nxt.arow * rstep : cA; const char* nB = has_next ? (const char*)g.Bt + (size_t)nxt.pn * tstep : cB;
        for (int t = 0; t < nt; t += 2) {
            const bool last = (t == nt - 2);
            const char* a1 = cA + (size_t)(t + 1) * kstep;
            const char* a2 = last ? nA : cA + (size_t)(t + 2) * kstep; const char* b2 = last ? nB : cB + (size_t)(t + 2) * kstep;
            const char* a3 = a2 + kstep; const char* b3 = b2 + kstep;
            if (last && has_next) S.a_ready(nxt);
            if constexpr (SP2) {
            PG8_LDB(B0, 0, 0); PG8_LDB(B1, 0, 1); PG8_SCHED; PG8_LDA(At, 0, 0); PG8_STAGE(PG8_SA(1, 1), a1 + hstep, voffA);
            PG8_WAIT_V(8); PG8_WAIT_L(0); PG8_BAR; PG8_MMA(0, 0, At, B0); PG8_MMA(0, 1, At, B1); PG8_BAR; PG8_SCHED;
            PG8_LDA(At, 0, 1); PG8_STAGE(PG8_SB(0, 0), b2, voffB); PG8_STAGE(PG8_SB(0, 1), b2 + hstep, voffB); PG8_STAGE(PG8_SA(0, 0), a2, voffA);
            PG8_WAIT_V(8); PG8_WAIT_L(0); PG8_BAR; PG8_MMA(1, 0, At, B0); PG8_MMA(1, 1, At, B1); PG8_BAR; PG8_SCHED;
            PG8_LDB(B0, 1, 0); PG8_LDB(B1, 1, 1); PG8_SCHED; PG8_LDA(At, 1, 0); PG8_STAGE(PG8_SA(0, 1), a2 + hstep, voffA);
            PG8_WAIT_V(8); PG8_WAIT_L(0); PG8_BAR; PG8_MMA(0, 0, At, B0); PG8_MMA(0, 1, At, B1); PG8_BAR; PG8_SCHED;
            PG8_LDA(At, 1, 1); PG8_STAGE(PG8_SB(1, 0), b3, voffB); PG8_STAGE(PG8_SB(1, 1), b3 + hstep, voffB); PG8_STAGE(PG8_SA(1, 0), a3, voffA);
            PG8_WAIT_V(8); PG8_WAIT_L(0); PG8_BAR; PG8_MMA(1, 0, At, B0); PG8_MMA(1, 1, At, B1); PG8_BAR; PG8_SCHED;
            } else {
            PG8_LDB(B0, 0, 0); PG8_SCHED; PG8_LDA(At, 0, 0); PG8_STAGE(PG8_SA(1, 1), a1 + hstep, voffA);
            PG8_WAIT_L(8); PG8_BAR; PG8_WAIT_L(0); PG8_MMA(0, 0, At, B0); PG8_BAR; PG8_SCHED;
            PG8_LDB(B1, 0, 1); PG8_STAGE(PG8_SB(0, 0), b2, voffB);
            PG8_BAR; PG8_WAIT_L(0); PG8_MMA(0, 1, At, B1); PG8_BAR;
            PG8_LDA(At, 0, 1); PG8_STAGE(PG8_SA(0, 0), a2, voffA);
            PG8_BAR; PG8_WAIT_L(0); PG8_MMA(1, 0, At, B0); PG8_BAR; PG8_SCHED;
            PG8_STAGE(PG8_SB(0, 1), b2 + hstep, voffB);
            PG8_WAIT_V(6); PG8_BAR; PG8_MMA(1, 1, At, B1); PG8_BAR;
            PG8_LDB(B0, 1, 0); PG8_SCHED; PG8_LDA(At, 1, 0); PG8_STAGE(PG8_SA(0, 1), a2 + hstep, voffA);
            PG8_WAIT_L(8); PG8_BAR; PG8_WAIT_L(0); PG8_MMA(0, 0, At, B0); PG8_BAR; PG8_SCHED;
            PG8_LDB(B1, 1, 1); PG8_STAGE(PG8_SB(1, 0), b3, voffB);
            PG8_BAR; PG8_WAIT_L(0); PG8_MMA(0, 1, At, B1); PG8_BAR;
            PG8_LDA(At, 1, 1); PG8_STAGE(PG8_SA(1, 0), a3, voffA);
            PG8_BAR; PG8_WAIT_L(0); PG8_MMA(1, 0, At, B0); PG8_BAR; PG8_SCHED;
            PG8_STAGE(PG8_SB(1, 1), b3 + hstep, voffB);
            PG8_WAIT_V(6); PG8_BAR; PG8_MMA(1, 1, At, B1); PG8_BAR;
            }
        }
        if constexpr (ALIGN_EPI) { if (wr == 0) PG8_BAR; }
        if constexpr (!Epi::AFTER_DRAIN) { E(acc, cur, wr, wc, fr, fq, lane); S.done(cur); }
        if (!has_next) break;
#pragma unroll
        for (int a = 0; a < 2; ++a)
#pragma unroll
            for (int b = 0; b < 2; ++b)
#pragma unroll
                for (int m = 0; m < 4; ++m)
#pragma unroll
                    for (int n = 0; n < 2; ++n) acc[a][b][m][n] = (f32x4){0.f, 0.f, 0.f, 0.f};
        cur = nxt; cA = nA; cB = nB; ++ui;
        if constexpr (ALIGN_EPI) { if (wr == 1) PG8_BAR; }
    }
    PG8_WAIT_V(0);
    if constexpr (!ALIGN_EPI) { if (wr == 0) PG8_BAR; }
    PG8_BAR;
    if constexpr (Epi::AFTER_DRAIN) { E.fused(acc, cur, wr, wc, fr, fq, lds, wid, lane); S.done(cur); }
#undef PG8_SA
#undef PG8_SB
#undef PG8_STAGE
#undef PG8_LDA
#undef PG8_LDB
#undef PG8_MMA
#undef PG8_WAIT_V
#undef PG8_WAIT_L
#undef PG8_BAR
#undef PG8_SCHED
}
}
namespace attn {
using bf16x8 = __attribute__((ext_vector_type(8))) short;
using s16x4  = __attribute__((ext_vector_type(4))) short;
using f32x16 = __attribute__((ext_vector_type(16))) float;
using u32x4  = __attribute__((ext_vector_type(4))) unsigned;
typedef unsigned short bf16_t;
typedef short v4i16_t __attribute__((ext_vector_type(4)));
#define ALAS __attribute__((address_space(3)))
constexpr int NW = 8, QBLK = 32, KVBLK = 64;
constexpr int KSLOT = 12 * 1024, VSLOT = 8 * 1024, LDS_K = 0, LDS_V = 3 * KSLOT, LDS_WS = LDS_V + 3 * VSLOT, LDS_BYTES = LDS_WS + NW * 64 * 4;
constexpr float THR = 8.f;
#define ASBAR() __builtin_amdgcn_sched_barrier(0)
__device__ __forceinline__ int crow(int r, int hi) { return (r & 3) + 8 * (r >> 2) + 4 * hi; }
typedef float f32x2_t __attribute__((ext_vector_type(2))); typedef __bf16 bf16x2_t __attribute__((ext_vector_type(2)));
__device__ __forceinline__ unsigned cvtpk(float lo, float hi) { f32x2_t v = {lo, hi}; bf16x2_t b = __builtin_convertvector(v, bf16x2_t); return __builtin_bit_cast(unsigned, b); }
__device__ __forceinline__ s16x4 vtr(const ALAS char* p) { return __builtin_bit_cast(s16x4, __builtin_amdgcn_ds_read_tr16_b64_v4i16((ALAS v4i16_t*)p)); }

#define APIN(x) asm volatile("" : "+v"(x))
__device__ __forceinline__ void glds16(const void* gsrc, unsigned lds_dst) { unsigned keep;
  asm volatile("s_mov_b32 %0, m0\n\ts_mov_b32 m0, %2\n\ts_nop 0\n\tglobal_load_lds_dwordx4 %1, off\n\ts_mov_b32 m0, %0" : "=&s"(keep) : "v"(gsrc), "s"(lds_dst) : "memory"); }
__device__ __forceinline__ void kload(bf16x8 (&kf)[12], const ALAS char* kp) {
#pragma unroll
  for (int d0 = 0; d0 < 6; ++d0) { kf[2 * d0] = *(const ALAS bf16x8*)(kp + d0 * 2048); kf[2 * d0 + 1] = *(const ALAS bf16x8*)(kp + d0 * 2048 + 512); }
}
__device__ __forceinline__ void blockA(f32x16& c0, f32x16& c1, const bf16x8 (&kf)[12], const bf16x8* qr, const f32x16& negm,
                                       const f32x16& p0, const f32x16& p1, float& l_reg, u32x4& pw0, u32x4& pw1, u32x4& pw2, u32x4& pw3,
                                       const ALAS char* vp, s16x4& v0l, s16x4& v0h, s16x4& v1l, s16x4& v1h, bf16x8 (&kn)[12], const ALAS char* kpn, bool GL) {
  float sacc = 0.f;
#define KRD(i) do { if (GL) { kn[2 * (i)] = *(const ALAS bf16x8*)(kpn + (i) * 2048); kn[2 * (i) + 1] = *(const ALAS bf16x8*)(kpn + (i) * 2048 + 512); } } while (0)
#define GAPA(MF, A0, A1, A2, A3, W0, W1, PW) do { MF; sacc += A0; sacc += A1; sacc += A2; sacc += A3; APIN(sacc); W0; W1; APIN(PW); ASBAR(); } while (0)
  GAPA(c0 = __builtin_amdgcn_mfma_f32_32x32x16_bf16(kf[0], qr[0], negm, 0, 0, 0), p0[0], p0[1], p0[2], p0[3],     pw0[0] = cvtpk(p0[0], p0[1]),   pw0[1] = cvtpk(p0[2], p0[3]), pw0);
  GAPA(c1 = __builtin_amdgcn_mfma_f32_32x32x16_bf16(kf[1], qr[0], negm, 0, 0, 0), p0[4], p0[5], p0[6], p0[7],     pw0[2] = cvtpk(p0[4], p0[5]),   pw0[3] = cvtpk(p0[6], p0[7]), pw0);
  GAPA(c0 = __builtin_amdgcn_mfma_f32_32x32x16_bf16(kf[2], qr[1], c0, 0, 0, 0),   p0[8], p0[9], p0[10], p0[11],   pw1[0] = cvtpk(p0[8], p0[9]),   pw1[1] = cvtpk(p0[10], p0[11]), pw1);
  GAPA(c1 = __builtin_amdgcn_mfma_f32_32x32x16_bf16(kf[3], qr[1], c1, 0, 0, 0),   p0[12], p0[13], p0[14], p0[15], pw1[2] = cvtpk(p0[12], p0[13]), pw1[3] = cvtpk(p0[14], p0[15]), pw1);
  GAPA(c0 = __builtin_amdgcn_mfma_f32_32x32x16_bf16(kf[4], qr[2], c0, 0, 0, 0),   p1[0], p1[1], p1[2], p1[3],     pw2[0] = cvtpk(p1[0], p1[1]),   pw2[1] = cvtpk(p1[2], p1[3]), pw2);
  GAPA(c1 = __builtin_amdgcn_mfma_f32_32x32x16_bf16(kf[5], qr[2], c1, 0, 0, 0),   p1[4], p1[5], p1[6], p1[7],     pw2[2] = cvtpk(p1[4], p1[5]),   pw2[3] = cvtpk(p1[6], p1[7]), pw2);
  GAPA(c0 = __builtin_amdgcn_mfma_f32_32x32x16_bf16(kf[6], qr[3], c0, 0, 0, 0),   p1[8], p1[9], p1[10], p1[11],   pw3[0] = cvtpk(p1[8], p1[9]),   pw3[1] = cvtpk(p1[10], p1[11]), pw3);
  GAPA(c1 = __builtin_amdgcn_mfma_f32_32x32x16_bf16(kf[7], qr[3], c1, 0, 0, 0),   p1[12], p1[13], p1[14], p1[15], pw3[2] = cvtpk(p1[12], p1[13]), pw3[3] = cvtpk(p1[14], p1[15]), pw3);
#undef GAPA
  l_reg += sacc;
  c0 = __builtin_amdgcn_mfma_f32_32x32x16_bf16(kf[8], qr[4], c0, 0, 0, 0);  v0l = vtr(vp); KRD(0); ASBAR();
  c1 = __builtin_amdgcn_mfma_f32_32x32x16_bf16(kf[9], qr[4], c1, 0, 0, 0);  v0h = vtr(vp + 512); KRD(1); ASBAR();
  c0 = __builtin_amdgcn_mfma_f32_32x32x16_bf16(kf[10], qr[5], c0, 0, 0, 0); v1l = vtr(vp + 4096); KRD(2); ASBAR();
  c1 = __builtin_amdgcn_mfma_f32_32x32x16_bf16(kf[11], qr[5], c1, 0, 0, 0); v1h = vtr(vp + 4096 + 512); KRD(3); ASBAR();
#undef KRD
}
__device__ __forceinline__ float rowmax(const f32x16& p0, const f32x16& p1) {
  float a = __builtin_fmaxf(__builtin_fmaxf(p0[0], p0[1]), p1[0]), b = __builtin_fmaxf(__builtin_fmaxf(p0[2], p0[3]), p1[1]); a = __builtin_fmaxf(__builtin_fmaxf(a, p1[2]), p1[3]);
#pragma unroll
  for (int r = 4; r < 16; r += 4) { a = __builtin_fmaxf(__builtin_fmaxf(a, p0[r]), p0[r + 1]); b = __builtin_fmaxf(__builtin_fmaxf(b, p0[r + 2]), p0[r + 3]);
    a = __builtin_fmaxf(__builtin_fmaxf(a, p1[r]), p1[r + 1]); b = __builtin_fmaxf(__builtin_fmaxf(b, p1[r + 2]), p1[r + 3]); }
  const float m = __builtin_fmaxf(a, b);
  auto rr = __builtin_amdgcn_permlane32_swap(__float_as_uint(m), __float_as_uint(m), false, false);
  return __builtin_fmaxf(__uint_as_float(rr[0]), __uint_as_float(rr[1]));
}
__device__ __forceinline__ void blockB(f32x16* o, const ALAS char* vp, const u32x4& pw0, const u32x4& pw1, const u32x4& pw2, const u32x4& pw3, f32x16& c0, f32x16& c1,
                                       s16x4 v0l, s16x4 v0h, s16x4 v1l, s16x4 v1h, bf16x8 (&kf)[12], const ALAS char* kpn, bool GL) {
#define KRD(i) do { if (GL) { kf[2 * (i)] = *(const ALAS bf16x8*)(kpn + (i) * 2048); kf[2 * (i) + 1] = *(const ALAS bf16x8*)(kpn + (i) * 2048 + 512); } } while (0)
#define VPK(L, H) (bf16x8){L[0], L[1], L[2], L[3], H[0], H[1], H[2], H[3]}
#define EX4(X, B) do { X[B] = __builtin_amdgcn_exp2f(X[B]); X[B + 1] = __builtin_amdgcn_exp2f(X[B + 1]); X[B + 2] = __builtin_amdgcn_exp2f(X[B + 2]); X[B + 3] = __builtin_amdgcn_exp2f(X[B + 3]); APIN(X); } while (0)
  s16x4 v2l, v2h, v3l, v3h;
  v2l = vtr(vp + 1024); v2h = vtr(vp + 1024 + 512); ASBAR();
  o[0] = __builtin_amdgcn_mfma_f32_32x32x16_bf16(__builtin_bit_cast(bf16x8, pw0), VPK(v0l, v0h), o[0], 0, 0, 0); EX4(c0, 0);  v3l = vtr(vp + 4096 + 1024); v3h = vtr(vp + 4096 + 1024 + 512); KRD(4); ASBAR();
  o[1] = __builtin_amdgcn_mfma_f32_32x32x16_bf16(__builtin_bit_cast(bf16x8, pw0), VPK(v1l, v1h), o[1], 0, 0, 0); EX4(c0, 4);  v0l = vtr(vp + 2048); v0h = vtr(vp + 2048 + 512); KRD(5); ASBAR();
  o[0] = __builtin_amdgcn_mfma_f32_32x32x16_bf16(__builtin_bit_cast(bf16x8, pw1), VPK(v2l, v2h), o[0], 0, 0, 0); EX4(c0, 8);  v1l = vtr(vp + 4096 + 2048); v1h = vtr(vp + 4096 + 2048 + 512); ASBAR();
  o[1] = __builtin_amdgcn_mfma_f32_32x32x16_bf16(__builtin_bit_cast(bf16x8, pw1), VPK(v3l, v3h), o[1], 0, 0, 0); EX4(c0, 12); v2l = vtr(vp + 3072); v2h = vtr(vp + 3072 + 512); ASBAR();
  o[0] = __builtin_amdgcn_mfma_f32_32x32x16_bf16(__builtin_bit_cast(bf16x8, pw2), VPK(v0l, v0h), o[0], 0, 0, 0); EX4(c1, 0);  v3l = vtr(vp + 4096 + 3072); v3h = vtr(vp + 4096 + 3072 + 512); ASBAR();
  o[1] = __builtin_amdgcn_mfma_f32_32x32x16_bf16(__builtin_bit_cast(bf16x8, pw2), VPK(v1l, v1h), o[1], 0, 0, 0); EX4(c1, 4);  ASBAR();
  o[0] = __builtin_amdgcn_mfma_f32_32x32x16_bf16(__builtin_bit_cast(bf16x8, pw3), VPK(v2l, v2h), o[0], 0, 0, 0); EX4(c1, 8);  ASBAR();
  o[1] = __builtin_amdgcn_mfma_f32_32x32x16_bf16(__builtin_bit_cast(bf16x8, pw3), VPK(v3l, v3h), o[1], 0, 0, 0); EX4(c1, 12); ASBAR();
#undef VPK
#undef EX4
#undef KRD
}
__device__ __forceinline__ void attn_unit(const bf16_t* __restrict__ Qb, const bf16_t* __restrict__ Kh, const bf16_t* __restrict__ Vh, bf16_t* __restrict__ Ob, int seq, ALAS char* lds, unsigned long long& att_probe_acc) {
  const int tid = threadIdx.x, wid = __builtin_amdgcn_readfirstlane(tid >> 6), lane = tid & 63, r32 = lane & 31, hi = lane >> 5;
  ALAS float* wsf = (ALAS float*)(lds + LDS_WS) + wid * 64;
  bf16x8 qr[6];
  const bf16_t* Qw = Qb + (long)(wid * QBLK + r32) * 768 + hi * 8;
#pragma unroll
  for (int d0 = 0; d0 < 6; ++d0) qr[d0] = *reinterpret_cast<const bf16x8*>(Qw + d0 * 16);
  const bool k2 = wid < 4;
  const bf16_t* ksrc0 = Kh + (long)lane * 768 + wid * 8; const bf16_t* ksrc1 = Kh + (long)lane * 768 + (8 + (wid & 3)) * 8;
  const bf16_t* vsrc = Vh + (long)(16 * (wid & 3) + (lane >> 2)) * 512 + (wid >> 2) * 32 + (lane & 3) * 8;
  const unsigned lds0 = (unsigned)(uintptr_t)lds;
  const unsigned kdst0 = lds0 + LDS_K + wid * 1024, kdst1 = lds0 + LDS_K + (8 + (wid & 3)) * 1024, vdst = lds0 + LDS_V + wid * 1024;
#define DMA_K(t, ko) do { glds16(ksrc0 + (long)(t) * (KVBLK * 768), (unsigned)__builtin_amdgcn_readfirstlane(kdst0 + (ko))); \
    if (k2) glds16(ksrc1 + (long)(t) * (KVBLK * 768), (unsigned)__builtin_amdgcn_readfirstlane(kdst1 + (ko))); } while (0)
#define DMA_V(t, vo) glds16(vsrc + (long)(t) * (KVBLK * 512), (unsigned)__builtin_amdgcn_readfirstlane(vdst + (vo)))
#define WAITBAR_ALL() asm volatile("s_waitcnt vmcnt(0) lgkmcnt(0)\n\ts_barrier" ::: "memory")
#define WAITBAR_STEADY() do { if (k2) asm volatile("s_waitcnt vmcnt(3) lgkmcnt(0)\n\ts_barrier" ::: "memory"); else asm volatile("s_waitcnt vmcnt(2) lgkmcnt(0)\n\ts_barrier" ::: "memory"); } while (0)
  const ALAS char* kp0 = lds + LDS_K + hi * 1024 + r32 * 16;
  const ALAS char* vp0 = lds + LDS_V + ((lane >> 4) & 1) * 32 + (lane & 3) * 8 + (4 * hi + ((lane & 15) >> 2)) * 64;
  float mhat = 0.f, l_reg = 0.f; f32x16 o[2]; o[0] = f32x16{}; o[1] = f32x16{}; f32x16 negm = f32x16{};
  bool resc = false;
#define DECIDE(C0, C1) do { const float rm = rowmax(C0, C1); resc = false; \
    if (__builtin_expect(__any(rm > THR), 0)) { const float dl = __builtin_fmaxf(rm, 0.f); mhat += dl; \
      _Pragma("unroll") for (int r = 0; r < 16; ++r) { C0[r] -= dl; C1[r] -= dl; } \
      _Pragma("unroll") for (int r = 0; r < 16; ++r) negm[r] = -mhat; \
      const float f = __builtin_amdgcn_exp2f(-dl); l_reg *= f; if (hi == 0) wsf[r32] = f; resc = true; } } while (0)
#define RESC() do { if (resc) { asm volatile("s_waitcnt lgkmcnt(0)" ::: "memory"); \
    _Pragma("unroll") for (int d = 0; d < 2; ++d) _Pragma("unroll") for (int r = 0; r < 16; ++r) o[d][r] *= wsf[crow(r, hi)]; } } while (0)
  f32x16 pA0, pA1, pB0, pB1; u32x4 pw0, pw1, pw2, pw3; bf16x8 kf[12]; const int NT = seq / KVBLK;
  int ko_cur = 0, ko_nxt = KSLOT, vo_prev = 0, vo_cur = 0, vo_nxt = VSLOT;
#define ROT() do { ko_cur = ko_nxt; ko_nxt = (ko_nxt == 2 * KSLOT) ? 0 : ko_nxt + KSLOT; vo_prev = vo_cur; vo_cur = vo_nxt; vo_nxt = (vo_nxt == 2 * VSLOT) ? 0 : vo_nxt + VSLOT; } while (0)
  DMA_K(0, 0); DMA_V(0, 0); DMA_K(1, KSLOT); DMA_K(2, 2 * KSLOT);
  WAITBAR_ALL();
  s16x4 v0l, v0h, v1l, v1h;
  kload(kf, kp0);
  { const f32x16 z = f32x16{}; u32x4 d0_, d1_, d2_, d3_; float ld_ = 0.f;
    blockA(pA0, pA1, kf, qr, negm, z, z, ld_, d0_, d1_, d2_, d3_, vp0, v0l, v0h, v1l, v1h, kf, kp0, false); }
  { const float rm = rowmax(pA0, pA1); mhat = rm;
#pragma unroll
    for (int r = 0; r < 16; ++r) { pA0[r] -= rm; pA1[r] -= rm; negm[r] = -rm; } }
#pragma unroll
  for (int r = 0; r < 16; ++r) { pA0[r] = __builtin_amdgcn_exp2f(pA0[r]); pA1[r] = __builtin_amdgcn_exp2f(pA1[r]); }
  WAITBAR_ALL();
  DMA_K(3, 0); DMA_V(1, VSLOT);
  ROT();
  kload(kf, kp0 + ko_cur);
  WAITBAR_STEADY();
#ifndef ATT_PROBE
#define ATT_PROBE 0
#endif
#if ATT_PROBE
#define TSTAMP(x) do { ASBAR(); asm volatile("s_memtime %0\n\ts_waitcnt lgkmcnt(0)" : "=s"(x) :: "memory"); ASBAR(); } while (0)
#define SEG(k, body) do { unsigned long long ta_, tb_; if (ATT_PROBE == (k)) TSTAMP(ta_); body; if (ATT_PROBE == (k)) { TSTAMP(tb_); att_probe_acc += tb_ - ta_; } } while (0)
#else
#define SEG(k, body) do { body; } while (0)
#endif
#define STEP(CN0, CN1, PP0, PP1, tt, GK, GV, GL) do { \
    SEG(1, ASBAR(); blockA(CN0, CN1, kf, qr, negm, PP0, PP1, l_reg, pw0, pw1, pw2, pw3, vp0 + vo_prev, v0l, v0h, v1l, v1h, kf, kp0 + ko_nxt, GL); ASBAR()); \
    SEG(2, if (GK) DMA_K((tt) + 3, ko_cur); if (GV) DMA_V((tt) + 1, vo_nxt); \
    DECIDE(CN0, CN1); ASBAR()); \
    SEG(3, blockB(o, vp0 + vo_prev, pw0, pw1, pw2, pw3, CN0, CN1, v0l, v0h, v1l, v1h, kf, kp0 + ko_nxt, GL); ASBAR(); \
    RESC()); } while (0)
  int t = 1;
  for (; t + 5 < NT; t += 2) {
    SEG(5, STEP(pB0, pB1, pA0, pA1, t, true, true, true);     SEG(4, WAITBAR_STEADY()); ROT(); \
    STEP(pA0, pA1, pB0, pB1, t + 1, true, true, true); SEG(4, WAITBAR_STEADY()); ROT());
  }
  for (; t + 1 < NT; t += 2) {
    STEP(pB0, pB1, pA0, pA1, t, (t + 3 < NT), (t + 1 < NT), (t + 1 < NT));     WAITBAR_ALL(); ROT();
    STEP(pA0, pA1, pB0, pB1, t + 1, (t + 4 < NT), (t + 2 < NT), (t + 2 < NT)); WAITBAR_ALL(); ROT();
  }
  STEP(pB0, pB1, pA0, pA1, t, false, false, false); WAITBAR_ALL(); ROT();
  { float s0 = 0.f;
#pragma unroll
    for (int r = 0; r < 16; ++r) s0 += pB0[r] + pB1[r];
    l_reg += s0;
    pw0 = (u32x4){cvtpk(pB0[0], pB0[1]), cvtpk(pB0[2], pB0[3]), cvtpk(pB0[4], pB0[5]), cvtpk(pB0[6], pB0[7])};
    pw1 = (u32x4){cvtpk(pB0[8], pB0[9]), cvtpk(pB0[10], pB0[11]), cvtpk(pB0[12], pB0[13]), cvtpk(pB0[14], pB0[15])};
    pw2 = (u32x4){cvtpk(pB1[0], pB1[1]), cvtpk(pB1[2], pB1[3]), cvtpk(pB1[4], pB1[5]), cvtpk(pB1[6], pB1[7])};
    pw3 = (u32x4){cvtpk(pB1[8], pB1[9]), cvtpk(pB1[10], pB1[11]), cvtpk(pB1[12], pB1[13]), cvtpk(pB1[14], pB1[15])};
    const ALAS char* vp = vp0 + vo_prev;
#define VFR(dh, ks) ({ const s16x4 lo_ = vtr(vp + (dh) * 4096 + (ks) * 1024), hi_ = vtr(vp + (dh) * 4096 + (ks) * 1024 + 512); (bf16x8){lo_[0], lo_[1], lo_[2], lo_[3], hi_[0], hi_[1], hi_[2], hi_[3]}; })
#pragma unroll
    for (int dh = 0; dh < 2; ++dh) {
      o[dh] = __builtin_amdgcn_mfma_f32_32x32x16_bf16(__builtin_bit_cast(bf16x8, pw0), VFR(dh, 0), o[dh], 0, 0, 0);
      o[dh] = __builtin_amdgcn_mfma_f32_32x32x16_bf16(__builtin_bit_cast(bf16x8, pw1), VFR(dh, 1), o[dh], 0, 0, 0);
      o[dh] = __builtin_amdgcn_mfma_f32_32x32x16_bf16(__builtin_bit_cast(bf16x8, pw2), VFR(dh, 2), o[dh], 0, 0, 0);
      o[dh] = __builtin_amdgcn_mfma_f32_32x32x16_bf16(__builtin_bit_cast(bf16x8, pw3), VFR(dh, 3), o[dh], 0, 0, 0); }
#undef VFR
  }
  { auto rr = __builtin_amdgcn_permlane32_swap(__float_as_uint(l_reg), __float_as_uint(l_reg), false, false); l_reg = __uint_as_float(rr[0]) + __uint_as_float(rr[1]); }
  if (hi == 0) wsf[32 + r32] = l_reg; asm volatile("s_waitcnt lgkmcnt(0)" ::: "memory");
  float rli[16];
#pragma unroll
  for (int r = 0; r < 16; ++r) rli[r] = __builtin_amdgcn_rcpf(wsf[32 + crow(r, hi)]);
  bf16_t* Ow = Ob + (long)(wid * QBLK) * 1024;
#pragma unroll
  for (int r = 0; r < 16; ++r) { const int orow = crow(r, hi);
#pragma unroll
    for (int d0 = 0; d0 < 2; ++d0) Ow[(long)orow * 1024 + d0 * 32 + r32] = (bf16_t)(cvtpk(o[d0][r] * rli[r], 0.f) & 0xffffu); }
  WAITBAR_ALL();
#undef DMA_K
#undef DMA_V
#undef WAITBAR_ALL
#undef WAITBAR_STEADY
#undef DECIDE
#undef RESC
#undef ROT
#undef STEP
}
#undef ASBAR
}
#define GAS __attribute__((address_space(1)))
#define LAS __attribute__((address_space(3)))
typedef unsigned short bf16;
typedef unsigned v4u __attribute__((ext_vector_type(4)));
typedef float f32x4 __attribute__((ext_vector_type(4)));
typedef short bf16x8 __attribute__((ext_vector_type(8)));
typedef GAS unsigned gu32;
typedef GAS unsigned long long gu64;
#define RLX_AGENT __ATOMIC_RELAXED, __HIP_MEMORY_SCOPE_AGENT
#define LDS_WAIT() asm volatile("s_waitcnt lgkmcnt(0)" ::: "memory")
#define VM_WAIT() asm volatile("s_waitcnt vmcnt(0)" ::: "memory")
__device__ __forceinline__ unsigned long long rt() { return __builtin_amdgcn_s_memrealtime(); }
__device__ __forceinline__ unsigned f2bf(float f) { unsigned u = __builtin_bit_cast(unsigned, f); return (u + 0x7fffu + ((u >> 16) & 1u)) >> 16; }
__device__ __forceinline__ unsigned pk2(float lo, float hi) { return f2bf(lo) | (f2bf(hi) << 16); }

#define XB_TMO      128
#define XB_XCNT(j)  (256  + 64 * (j))
#define XB_XSUB(j)  (1280 + 64 * (j))
#define XB_XGEN(j)  (2304 + 64 * (j))
#define XB_TOP      3328
#define XB_TOPGEN   3392
#define XCD_BAR_WORDS 3456
#define XB_SPIN_CAP (1u << 18)

__device__ __forceinline__ unsigned xb_ld(unsigned* p)              { return __hip_atomic_load(p, __ATOMIC_RELAXED, __HIP_MEMORY_SCOPE_AGENT); }
__device__ __forceinline__ unsigned xb_add(unsigned* p, unsigned v) { return __hip_atomic_fetch_add(p, v, __ATOMIC_RELAXED, __HIP_MEMORY_SCOPE_AGENT); }
__device__ __forceinline__ unsigned xb_xcc_id() { return (unsigned)__builtin_amdgcn_s_getreg((3 << 11) | 20) & 0xFu; }
#define XB_SPIN(cond, bar) do { unsigned _sp = 0; while (cond) { __builtin_amdgcn_s_sleep(1); \
    if ((++_sp & 255u) == 0u) { if (xb_ld(&(bar)[XB_TMO])) break; if (_sp > XB_SPIN_CAP) { atomicAdd(&(bar)[XB_TMO], 1u); break; } } } } while (0)

struct XcdBarrier {
    unsigned* bar; unsigned x;
    volatile LAS unsigned* st;
};

__device__ __forceinline__ XcdBarrier xcd_barrier_post(unsigned* bar, volatile LAS unsigned* st) {
    XcdBarrier b; b.bar = bar; b.x = xb_xcc_id(); b.st = st;
    if (threadIdx.x == 0) (void)xb_add(&bar[XB_XCNT(b.x)], 1u);
    return b;
}
__device__ __forceinline__ void xcd_barrier_complete(unsigned* bar, unsigned x, unsigned& nloc, unsigned& nx) {
    const unsigned G = gridDim.x * gridDim.y * gridDim.z;
    unsigned sum, cnt, mine, sp = 0u;
    for (;;) {
        sum = 0u; cnt = 0u; mine = 0u;
#pragma unroll
        for (unsigned j = 0; j < 16; ++j) { const unsigned c = xb_ld(&bar[XB_XCNT(j)]); sum += c; cnt += (c > 0u) ? 1u : 0u; mine = (j == x) ? c : mine; }
        if (sum == G) break;
        __builtin_amdgcn_s_sleep(1);
        if ((++sp & 255u) == 0u) { if (xb_ld(&bar[XB_TMO])) break; if (sp > XB_SPIN_CAP) { atomicAdd(&bar[XB_TMO], 1u); break; } }
    }
    nloc = mine > 0u ? mine : 1u; nx = cnt > 0u ? cnt : 1u;
}

__device__ __forceinline__ void xcd_barrier(const XcdBarrier& b) {
    asm volatile("s_waitcnt vmcnt(0)" ::: "memory");
    __syncthreads();
    if (threadIdx.x == 0) {
        unsigned* bar = b.bar;
        __builtin_amdgcn_s_waitcnt(0);
        unsigned nloc = b.st[0], nx = b.st[1];
        if (nloc == 0u) { xcd_barrier_complete(bar, b.x, nloc, nx); b.st[0] = nloc; b.st[1] = nx; }
        const unsigned old = xb_add(&bar[XB_XSUB(b.x)], 1u);
        const unsigned gen = old / nloc;
        if (old + 1u == (gen + 1u) * nloc) {
            __builtin_amdgcn_fence(__ATOMIC_RELEASE, "agent");
            asm volatile("s_waitcnt vmcnt(0)" ::: "memory");
            const unsigned og = xb_add(&bar[XB_TOP], 1u);
            const unsigned tg = og / nx;
            if (og + 1u == (tg + 1u) * nx) xb_add(&bar[XB_TOPGEN], 1u);
            else XB_SPIN(xb_ld(&bar[XB_TOPGEN]) == tg, bar);
            __builtin_amdgcn_fence(__ATOMIC_ACQUIRE, "agent");
            xb_add(&bar[XB_XGEN(b.x)], 1u);
            asm volatile("s_waitcnt vmcnt(0)" ::: "memory");
        } else {
            XB_SPIN(xb_ld(&bar[XB_XGEN(b.x)]) == gen, bar);
            __builtin_amdgcn_fence(__ATOMIC_ACQUIRE, "agent");
            asm volatile("s_waitcnt vmcnt(0)" ::: "memory");
        }
    }
    __syncthreads();
}

constexpr int NWAVES = 8;
#ifndef MK_N_LAUNCHES
#define MK_N_LAUNCHES 1
#endif
#ifndef MK_COOP
#define MK_COOP 1
#endif
constexpr int N_PHASES = 10;
constexpr int N_LAUNCHES = MK_N_LAUNCHES;

constexpr size_t MiB = 1u << 20;
constexpr size_t WS_CTL = 0, CTL_ZERO_BYTES = 65536;
constexpr size_t WS_COS = 1 * MiB, WS_SIN = 1 * MiB + 512 * 1024;
constexpr size_t WS_SSQ1 = 2 * MiB, WS_SSQ2 = 3 * MiB, WS_SSQ3 = 4 * MiB;
constexpr size_t WS_W1 = 5 * MiB;
constexpr size_t WS_WUQ = 9 * MiB;
constexpr size_t WS_WUKV = WS_WUQ + 768 * 512;
constexpr size_t WS_WO = 29 * MiB;
constexpr size_t WS_WUP = 12 * MiB + 512 * 1024;
constexpr size_t WS_WDN = 23 * MiB + 512 * 1024;
constexpr size_t WS_WG = 10 * MiB + 512 * 1024;
constexpr size_t WS_WPJ = WS_WUKV + 1024 * 512;
constexpr size_t WS_HB = 32 * MiB;
constexpr size_t WS_Z = 64 * MiB;
constexpr size_t WS_Q = 128 * MiB;
constexpr size_t WS_K = 152 * MiB;
constexpr size_t WS_V = 176 * MiB;
constexpr size_t WS_XB = 152 * MiB;
constexpr size_t WS_QN = 192 * MiB, WS_KVN = 200 * MiB, WS_PB = 208 * MiB;
constexpr size_t WS_PP = 216 * MiB;
constexpr size_t WS_END = 248 * MiB;
static_assert(WS_Z + (size_t)M * DFF * 2 <= WS_K && WS_WDN + (size_t)DM * DFF * 2 <= WS_WO && WS_WO + 2 * MiB <= WS_HB && WS_WPJ + 1024 * 512 <= WS_WG && WS_WG + 2 * MiB <= WS_WUP && WS_WUP + 11 * MiB <= WS_WDN, "d_ws map");
static_assert(WS_KVN == WS_QN + (size_t)M * 512 && WS_PB == WS_KVN + (size_t)M * 512, "P3 reads [qn | kvn | pb] as one A operand");
constexpr int CW_BAR = 1024;

constexpr int RING_OFF = 0, RING_BYTES = 131072;
constexpr int MISC_OFF = RING_BYTES, HALO_OFF = RING_BYTES + 512, RSTD_OFF = HALO_OFF + 8192;
constexpr int LDS_BYTES = 147456;
static_assert(RSTD_OFF + 6 * 1024 <= LDS_BYTES, "LDS map");

struct Frame {
    LAS unsigned char* lds;
    int tid, lane, wave, vcu, G;
};

__device__ __forceinline__ float wave_sum(float v) {
#pragma unroll
    for (int o = 1; o < 64; o <<= 1) v += __shfl_xor(v, o);
    return v;
}
struct TrItem { const float* W; bf16* WT; const float* gain; int N, ldk, k0, n0, r0; };
__device__ __forceinline__ void tr_load(const TrItem& t, int lane, f32x4 (&v)[8], float (&gn)[8]) {
    const int n4 = (lane & 7) * 4, kr = lane >> 3;
#pragma unroll
    for (int i = 0; i < 8; ++i) { v[i] = *(const GAS f32x4*)(t.W + (size_t)(t.k0 + kr + 8 * i) * t.N + t.n0 + n4); gn[i] = t.gain ? t.gain[t.k0 + kr + 8 * i] : 1.0f; }
}
__device__ __forceinline__ void tr_store(const TrItem& t, int lane, const f32x4 (&v)[8], const float (&gn)[8], LAS float* scr) {
    const int n4 = (lane & 7) * 4, kr = lane >> 3;
#pragma unroll
    for (int i = 0; i < 8; ++i) { LAS float* d = scr + (kr + 8 * i) * 33 + n4; d[0] = v[i][0] * gn[i]; d[1] = v[i][1] * gn[i]; d[2] = v[i][2] * gn[i]; d[3] = v[i][3] * gn[i]; }
    LDS_WAIT(); asm volatile("" ::: "memory");
    const int c = lane & 7;
#pragma unroll
    for (int j = 0; j < 4; ++j) { const int n = (lane >> 3) + 8 * j; const LAS float* s = scr + (8 * c) * 33 + n;
        v4u o; o.x = pk2(s[0 * 33], s[1 * 33]); o.y = pk2(s[2 * 33], s[3 * 33]); o.z = pk2(s[4 * 33], s[5 * 33]); o.w = pk2(s[6 * 33], s[7 * 33]);
        *(GAS v4u*)(t.WT + (size_t)(t.r0 + n) * t.ldk + t.k0 + 8 * c) = o; }
    LDS_WAIT(); asm volatile("" ::: "memory");
}

struct Ptrs {
    const float *x, *p, *g_mix, *w_in, *conv_w, *g_q, *w_uq, *g_kv, *w_ukv, *w_o, *g_ffn, *w_up, *fcw, *fcb, *w_down, *g_ple, *w_gate, *w_proj, *g_final;
    float* out; unsigned char* ws;
};

__device__ __forceinline__ bool tr_decode(const Ptrs& P, unsigned char* ws, int it, TrItem& t) {
    constexpr int I_W1 = (DM / 64) * (DIN / 32), I_UQ = (QLORA / 64) * (768 / 32), I_UKV = (KVLORA / 64) * (1024 / 32), I_O = (DM / 64) * (DM / 32),
                  I_UP = (DM / 64) * (NUP / 32), I_DN = (DFF / 64) * (DM / 32), I_G = I_O, I_PJ = (PLE / 64) * (DM / 32);
    constexpr int NITEMS = I_W1 + I_UQ + I_UKV + I_O + I_UP + I_DN + I_G + I_PJ;
    if (it >= NITEMS) return false;
    int r = it, map = 0;
    if (r < I_UP) { t.W = P.w_up; t.N = NUP; t.WT = (bf16*)(ws + WS_WUP); t.ldk = DM; t.gain = P.g_ffn; map = 1; }
    else if ((r -= I_UP) < I_DN) { t.W = P.w_down; t.N = DM; t.WT = (bf16*)(ws + WS_WDN); t.ldk = DFF; t.gain = nullptr; }
    else if ((r -= I_DN) < I_W1) { t.W = P.w_in; t.N = DIN; t.WT = (bf16*)(ws + WS_W1); t.ldk = DM; t.gain = P.g_mix; }
    else if ((r -= I_W1) < I_O) { t.W = P.w_o; t.N = DM; t.WT = (bf16*)(ws + WS_WO); t.ldk = DM; t.gain = nullptr; }
    else if ((r -= I_O) < I_G) { t.W = P.w_gate; t.N = DM; t.WT = (bf16*)(ws + WS_WG); t.ldk = DM; t.gain = P.g_ple; }
    else if ((r -= I_G) < I_PJ) { t.W = P.w_proj; t.N = DM; t.WT = (bf16*)(ws + WS_WPJ); t.ldk = PLE; t.gain = nullptr; }
    else if ((r -= I_PJ) < I_UQ) { t.W = P.w_uq; t.N = 768; t.WT = (bf16*)(ws + WS_WUQ); t.ldk = QLORA; t.gain = P.g_q; }
    else { r -= I_UQ; t.W = P.w_ukv; t.N = 1024; t.WT = (bf16*)(ws + WS_WUKV); t.ldk = 256; t.gain = P.g_kv; }
    const int nblk = t.N / 32; t.k0 = 64 * (r / nblk); t.n0 = 32 * (r % nblk);
    t.r0 = map ? ((t.n0 < DFF) ? (256 * (t.n0 / 128) + (t.n0 % 128)) : (256 * ((t.n0 - DFF) / 128) + 128 + ((t.n0 - DFF) % 128))) : t.n0;
    return true;
}
__device__ __forceinline__ void p0_prologue(Frame& F, const Ptrs& P) {
    unsigned char* ws = P.ws;
    LAS float* scr = (LAS float*)(F.lds + RING_OFF + F.wave * 16384);
    const int gw = F.vcu * NWAVES + F.wave, NGW = F.G * NWAVES;
    const int gt = F.vcu * (NWAVES * 64) + F.tid, NGT = F.G * NWAVES * 64;
    for (int m0 = gw; m0 < M; m0 += 4 * NGW) {
        f32x4 v[4][4];
#pragma unroll
        for (int q = 0; q < 4; ++q) { const int m = m0 + q * NGW; if (m < M) { const GAS f32x4* xr = (const GAS f32x4*)(P.x + (size_t)m * DM) + F.lane;
#pragma unroll
            for (int j = 0; j < 4; ++j) v[q][j] = xr[64 * j]; } }
#pragma unroll
        for (int q = 0; q < 4; ++q) { const int m = m0 + q * NGW; if (m < M) { float s = 0.f;
#pragma unroll
            for (int j = 0; j < 4; ++j) s += (v[q][j].x * v[q][j].x + v[q][j].y * v[q][j].y) + (v[q][j].z * v[q][j].z + v[q][j].w * v[q][j].w);
            const float rstd = rsqrtf(wave_sum(s) * (1.f / DM) + EPS);
            GAS unsigned long long* o8 = (GAS unsigned long long*)(ws + WS_HB + (size_t)m * DM * 2) + F.lane;
#pragma unroll
            for (int j = 0; j < 4; ++j) o8[64 * j] = (unsigned long long)pk2(v[q][j].x * rstd, v[q][j].y * rstd) | ((unsigned long long)pk2(v[q][j].z * rstd, v[q][j].w * rstd) << 32); } }
    }
    { TrItem tc, tn; f32x4 vc[8], vn[8]; float gc[8], gn[8];
      int it = gw; bool have = tr_decode(P, ws, it, tc);
      if (have) tr_load(tc, F.lane, vc, gc);
      while (have) {
          const bool more = tr_decode(P, ws, it + NGW, tn);
          if (more) tr_load(tn, F.lane, vn, gn);
          tr_store(tc, F.lane, vc, gc, scr);
          if (more) { tc = tn;
#pragma unroll
              for (int i = 0; i < 8; ++i) { vc[i] = vn[i]; gc[i] = gn[i]; } }
          have = more; it += NGW;
      } }
    const v4u zero4 = {0u, 0u, 0u, 0u};
    for (int i = gt; i < 12288; i += NGT) *(GAS v4u*)(ws + WS_W1 + (size_t)DIN * DM * 2 + (size_t)i * 16) = zero4;
    for (int i = gt; i < 16384; i += NGT) *(GAS v4u*)(ws + WS_WUKV + (size_t)(i >> 4) * 512 + 256 + (size_t)(i & 15) * 16) = zero4;
    for (int i = gt; i < SEQ * 16; i += NGT) {
        const int pos = i >> 4, j = i & 15;
        constexpr float INVF[16] = {1.0f, 0.5623413324356079f, 0.3162277638912201f, 0.17782793939113617f, 0.10000000149011612f, 0.05623413249850273f, 0.03162277489900589f, 0.017782794311642647f,
                                    0.009999999776482582f, 0.005623413249850273f, 0.003162277629598975f, 0.0017782794311642647f, 0.0010000000474974513f, 0.000562341301701963f, 0.0003162277571391314f, 0.00017782794020604342f};
        const float invf = INVF[j];
        const float ang = (float)pos * invf;
        const double t = (double)ang * 0.15915494309189533577;
        const float fr = (float)(t - __builtin_floor(t));
        ((GAS float*)(ws + WS_COS))[i] = __builtin_amdgcn_cosf(fr); ((GAS float*)(ws + WS_SIN))[i] = __builtin_amdgcn_sinf(fr);
    }
    for (int i0 = gt; i0 < M * PLE / 8; i0 += 4 * NGT) {
        f32x4 a[4], b[4];
#pragma unroll
        for (int q = 0; q < 4; ++q) { const int i = i0 + q * NGT; if (i < M * PLE / 8) { a[q] = *(const GAS f32x4*)(P.p + (size_t)i * 8); b[q] = *(const GAS f32x4*)(P.p + (size_t)i * 8 + 4); } }
#pragma unroll
        for (int q = 0; q < 4; ++q) { const int i = i0 + q * NGT; if (i < M * PLE / 8) {
            v4u o; o.x = pk2(a[q][0], a[q][1]); o.y = pk2(a[q][2], a[q][3]); o.z = pk2(b[q][0], b[q][1]); o.w = pk2(b[q][2], b[q][3]);
            *(GAS v4u*)(ws + WS_PB + (size_t)i * 16) = o; } }
    }
}

__device__ __forceinline__ float bf_lo(unsigned w) { return __uint_as_float(w << 16); }
__device__ __forceinline__ float bf_hi(unsigned w) { return __uint_as_float(w & 0xffff0000u); }

__device__ __forceinline__ void p2_mixer_prep(Frame& F, const Ptrs& P) {
    unsigned char* ws = P.ws;
    const int gw = F.vcu * NWAVES + F.wave, NGW = F.G * NWAVES, lane = F.lane;
    const bf16* Z = (const bf16*)(ws + WS_Z);
    constexpr int NB = 4;
    float cw0[8], cw1[8], cw2[8];
#pragma unroll
    for (int j = 0; j < 8; ++j) { cw0[j] = P.conv_w[8 * lane + j]; cw1[j] = P.conv_w[CONVW + 8 * lane + j]; cw2[j] = P.conv_w[2 * CONVW + 8 * lane + j]; }
    const float* cosT = (const float*)(ws + WS_COS); const float* sinT = (const float*)(ws + WS_SIN);
    const int l32 = lane & 31, i16 = lane & 15;
    for (int blk = gw; blk < M / NB; blk += NGW) {
        const int m0 = blk * NB, t0 = m0 & (SEQ - 1);
        const bf16* zr = Z + (size_t)m0 * DINP;
        const v4u zero4 = {0u, 0u, 0u, 0u};
        v4u xc[NB + 2], cg[NB + 2], bgv[NB]; unsigned long long ql[NB]; unsigned kvl[NB]; unsigned krv[NB]; float cs[NB], sn[NB];
#pragma unroll
        for (int r = 0; r < NB + 2; ++r) { const int t = t0 + r - 1; const bool ok = (t >= 0) && (t < SEQ);
            xc[r] = ok ? *(const GAS v4u*)(zr + (r - 1) * DINP + 8 * lane) : zero4; cg[r] = ok ? *(const GAS v4u*)(zr + (r - 1) * DINP + 1024 + 8 * lane) : zero4; }
#pragma unroll
        for (int r = 0; r < NB; ++r) { const bf16* z1 = zr + r * DINP;
            bgv[r] = *(const GAS v4u*)(z1 + 512 + 8 * lane); ql[r] = *(const GAS unsigned long long*)(z1 + 1536 + 4 * lane); kvl[r] = *(const GAS unsigned*)(z1 + 1792 + 2 * lane);
            krv[r] = z1[1920 + l32]; cs[r] = cosT[(t0 + r) * 16 + i16]; sn[r] = sinT[(t0 + r) * 16 + i16]; }
        float u[NB + 2][8];
#pragma unroll
        for (int r = 0; r < NB + 2; ++r)
#pragma unroll
            for (int q = 0; q < 4; ++q) { u[r][2 * q] = bf_lo(xc[r][q]) * bf_lo(cg[r][q]); u[r][2 * q + 1] = bf_hi(xc[r][q]) * bf_hi(cg[r][q]); }
#pragma unroll
        for (int r = 0; r < NB; ++r) { v4u yo;
#pragma unroll
            for (int q = 0; q < 4; ++q) {
                const float yl = bf_lo(bgv[r][q]) * (cw0[2 * q] * u[r][2 * q] + cw1[2 * q] * u[r + 1][2 * q] + cw2[2 * q] * u[r + 2][2 * q]);
                const float yh = bf_hi(bgv[r][q]) * (cw0[2 * q + 1] * u[r][2 * q + 1] + cw1[2 * q + 1] * u[r + 1][2 * q + 1] + cw2[2 * q + 1] * u[r + 2][2 * q + 1]);
                yo[q] = pk2(yl, yh); }
            *(GAS v4u*)(ws + WS_HB + ((size_t)(m0 + r) * DM + 8 * lane) * 2) = yo; }
        float sq[NB], sk[NB];
#pragma unroll
        for (int r = 0; r < NB; ++r) { const float a = bf_lo((unsigned)ql[r]), b = bf_hi((unsigned)ql[r]), c = bf_lo((unsigned)(ql[r] >> 32)), d = bf_hi((unsigned)(ql[r] >> 32));
            sq[r] = (a * a + b * b) + (c * c + d * d); const float e = bf_lo(kvl[r]), f = bf_hi(kvl[r]); sk[r] = e * e + f * f; }
#pragma unroll
        for (int o = 1; o < 64; o <<= 1) {
#pragma unroll
            for (int r = 0; r < NB; ++r) { sq[r] += __shfl_xor(sq[r], o); sk[r] += __shfl_xor(sk[r], o); } }
#pragma unroll
        for (int r = 0; r < NB; ++r) { const size_t m = (size_t)(m0 + r);
            const float rq = rsqrtf(sq[r] * (1.f / QLORA) + EPS), rk = rsqrtf(sk[r] * (1.f / KVLORA) + EPS);
            const float a = bf_lo((unsigned)ql[r]), b = bf_hi((unsigned)ql[r]), c = bf_lo((unsigned)(ql[r] >> 32)), d = bf_hi((unsigned)(ql[r] >> 32));
            *(GAS unsigned long long*)(ws + WS_QN + (m * 256 + 4 * lane) * 2) = (unsigned long long)pk2(a * rq, b * rq) | ((unsigned long long)pk2(c * rq, d * rq) << 32);
            *(GAS unsigned*)(ws + WS_KVN + (m * 256 + 2 * lane) * 2) = pk2(bf_lo(kvl[r]) * rk, bf_hi(kvl[r]) * rk);
            *(GAS unsigned*)(ws + WS_KVN + (m * 256 + 128 + 2 * lane) * 2) = 0u;
            const float xv = __uint_as_float(krv[r] << 16), pv = __shfl_xor(xv, 16);
            const float o = (l32 < 16) ? (xv * cs[r] - pv * sn[r]) : (xv * cs[r] + pv * sn[r]);
            const bf16 ob = (bf16)f2bf(o);
            if (lane < 32) {
#pragma unroll
                for (int h = 0; h < NH; ++h) ((GAS bf16*)(ws + WS_K))[m * LDKK + h * QKD + NOPE + l32] = ob; }
        }
    }
}

__device__ __forceinline__ void p9_final_norm(Frame& F, const Ptrs& P) {
    const int gw = F.vcu * NWAVES + F.wave, NGW = F.G * NWAVES;
    const float* ssq = (const float*)(P.ws + WS_SSQ3);
    f32x4 g[2][2];
#pragma unroll
    for (int j = 0; j < 2; ++j) { g[j][0] = *(const GAS f32x4*)(P.g_final + 512 * j + 8 * F.lane); g[j][1] = *(const GAS f32x4*)(P.g_final + 512 * j + 8 * F.lane + 4); }
    for (int m = gw; m < M; m += NGW) {
        const float rs = pg8::rstd16(ssq, m);
        const bf16* xr = (const bf16*)(P.ws + WS_XB) + (size_t)m * DM + 8 * F.lane; float* orow = P.out + (size_t)m * DM + 8 * F.lane;
#pragma unroll
        for (int j = 0; j < 2; ++j) { const v4u w = *(const GAS v4u*)(xr + 512 * j);
            const f32x4 a = {bf_lo(w.x), bf_hi(w.x), bf_lo(w.y), bf_hi(w.y)}, b = {bf_lo(w.z), bf_hi(w.z), bf_lo(w.w), bf_hi(w.w)};
            *(GAS f32x4*)(orow + 512 * j) = a * rs * g[j][0]; *(GAS f32x4*)(orow + 512 * j + 4) = b * rs * g[j][1]; }
    }
}

struct Args { const float* in[19]; float* out; unsigned char* ws; int ph_lo, ph_hi; };
__global__ void __launch_bounds__(NWAVES * 64, 2) mk_fwd(Args args) {
    extern __shared__ __attribute__((aligned(16))) unsigned char lds[];
    Frame F;
    F.lds = (LAS unsigned char*)lds;
    F.tid = threadIdx.x; F.lane = F.tid & 63; F.wave = __builtin_amdgcn_readfirstlane(F.tid >> 6);
    F.G = gridDim.x; { const int bx = blockIdx.x; F.vcu = (F.G % 8 == 0) ? (bx % 8) * (F.G / 8) + bx / 8 : bx; }
    Ptrs P;
    P.x = args.in[0]; P.p = args.in[1]; P.g_mix = args.in[2]; P.w_in = args.in[3]; P.conv_w = args.in[4]; P.g_q = args.in[5]; P.w_uq = args.in[6]; P.g_kv = args.in[7];
    P.w_ukv = args.in[8]; P.w_o = args.in[9]; P.g_ffn = args.in[10]; P.w_up = args.in[11]; P.fcw = args.in[12]; P.fcb = args.in[13]; P.w_down = args.in[14];
    P.g_ple = args.in[15]; P.w_gate = args.in[16]; P.w_proj = args.in[17]; P.g_final = args.in[18]; P.out = args.out; P.ws = args.ws;
    unsigned char* ws = args.ws;
    volatile LAS unsigned* MISC = (volatile LAS unsigned*)(F.lds + MISC_OFF);
    if (F.tid < 128) MISC[F.tid] = 0u;
    __syncthreads();
    XcdBarrier bar; bar.bar = (unsigned*)(ws + WS_CTL) + CW_BAR; bar.x = 0; bar.st = nullptr;
    if (N_LAUNCHES == 1) bar = xcd_barrier_post((unsigned*)(ws + WS_CTL) + CW_BAR, MISC + 8);
    const int lo = args.ph_lo, hi = args.ph_hi;
#ifndef PROBE_A
#define PROBE_A -1
#define PROBE_B -1
#endif
#if PROBE_A >= 0
    unsigned long long tsa = 0;
#define STAMP_BEGIN(k) do { if ((k) == PROBE_A && blockIdx.x == 0 && F.tid == 0) tsa = __builtin_amdgcn_s_memrealtime(); } while (0)
#define STAMP(k) do { if ((k) == PROBE_B) { if (blockIdx.x == 0 && F.tid == 0) { const unsigned long long tb = __builtin_amdgcn_s_memrealtime(), dt = tb - tsa; \
        while (__builtin_amdgcn_s_memrealtime() - tb < dt) __builtin_amdgcn_s_sleep(8); } xcd_barrier(bar); } } while (0)
#else
#define STAMP_BEGIN(k) do {} while (0)
#define STAMP(k) do {} while (0)
#endif
#ifndef PHMASK
#define PHMASK 0x3ff
#endif
#define IN(k) (((PHMASK >> (k)) & 1) && lo <= (k) && (k) < hi)
#ifndef DUPMASK
#define DUPMASK 0
#endif
#define DUP(k) ((DUPMASK >> (k)) & 1)
#define SEAM(k) do { if (IN(k) && IN((k) + 1)) xcd_barrier(bar); STAMP(k); } while (0)

    STAMP_BEGIN(0);
    if (IN(0)) { p0_prologue(F, P); if (DUP(0)) p0_prologue(F, P); } SEAM(0);

    STAMP_BEGIN(1);
    if (IN(1)) {
        pg8::Gemm g{(const pg8::bf16_t*)(ws + WS_HB), (const pg8::bf16_t*)(ws + WS_W1), M, DINP, DM}; pg8::DupOrder<pg8::StaticOrder, DUP(1)> S; S.init(M, DINP, F.G, (int)blockIdx.x);
        pg8::EpiStoreBf16 E{(pg8::bf16_t*)(ws + WS_Z), DINP};
        pg8::gemm_phase<pg8::EpiStoreBf16, pg8::DupOrder<pg8::StaticOrder, DUP(1)>, true, true>(F.lds + RING_OFF, g, S, E);
    } SEAM(1);

    STAMP_BEGIN(2);
    if (IN(2)) { p2_mixer_prep(F, P); if (DUP(2)) p2_mixer_prep(F, P); } SEAM(2);

    STAMP_BEGIN(3);
    if (IN(3)) {
        pg8::Gemm g{(const pg8::bf16_t*)(ws + WS_QN), (const pg8::bf16_t*)(ws + WS_WUQ), 3 * M, 2816, 256}; pg8::DupOrder<pg8::P3Order, DUP(3)> S; S.G = F.G; S.c = (int)blockIdx.x;
        pg8::EpiP3 E{(pg8::bf16_t*)(ws + WS_Q), (pg8::bf16_t*)(ws + WS_K), (pg8::bf16_t*)(ws + WS_V), (pg8::bf16_t*)(ws + WS_PP), (const float*)(ws + WS_COS), (const float*)(ws + WS_SIN), QSCALE};
        pg8::gemm_phase<pg8::EpiP3, pg8::DupOrder<pg8::P3Order, DUP(3)>, true, true>(F.lds + RING_OFF, g, S, E);
    } SEAM(3);

    STAMP_BEGIN(4);
    if (IN(4)) {
        static_assert(attn::LDS_BYTES <= RING_BYTES, "attention LDS");
        const int nunits = BATCH * NH * (SEQ / 256);
        unsigned long long att_acc = 0;
        for (int i = 0; ; ++i) {
            const int ii = DUP(4) ? (i >> 1) : i;
            const int uidx = (F.G == 256) ? (((F.vcu >> 5) * 2 + ii) * 32 + (F.vcu & 31)) : (ii * F.G + F.vcu);
            if ((F.G == 256 && ii >= 2) || uidx >= nunits) break;
            const int pair = uidx >> 5, qb = uidx & 31, b = pair >> 3, h = pair & 7;
            const size_t row0 = (size_t)b * SEQ;
            attn::attn_unit((const attn::bf16_t*)(ws + WS_Q) + (row0 + qb * 256) * LDQ + h * QKD, (const attn::bf16_t*)(ws + WS_K) + row0 * LDKK + h * QKD,
                            (const attn::bf16_t*)(ws + WS_V) + row0 * LDV + h * VH, (attn::bf16_t*)(ws + WS_HB) + (row0 + qb * 256) * DM + CONVW + h * VH, SEQ, (__attribute__((address_space(3))) char*)(F.lds + RING_OFF), att_acc);
        }
#if ATT_PROBE
        if (blockIdx.x == 0 && F.tid == 0) { const unsigned long long t0 = __builtin_amdgcn_s_memtime(); while (__builtin_amdgcn_s_memtime() - t0 < att_acc) __builtin_amdgcn_s_sleep(8); }
#endif
    } SEAM(4);

    STAMP_BEGIN(5);
    if (IN(5)) {
        pg8::Gemm g{(const pg8::bf16_t*)(ws + WS_HB), (const pg8::bf16_t*)(ws + WS_WO), M, DM, DM}; pg8::DupOrder<pg8::StaticOrder, DUP(5)> S; S.init(M, DM, F.G, (int)blockIdx.x);
        pg8::EpiRes<false> E{P.x, nullptr, (pg8::bf16_t*)(ws + WS_XB), (float*)(ws + WS_SSQ1)};
        pg8::gemm_phase<pg8::EpiRes<false>, pg8::DupOrder<pg8::StaticOrder, DUP(5)>, true, true>(F.lds + RING_OFF, g, S, E);
    } SEAM(5);

    STAMP_BEGIN(6);
    if (IN(6)) {
        pg8::Gemm g{(const pg8::bf16_t*)(ws + WS_XB), (const pg8::bf16_t*)(ws + WS_WUP), M, NUP, DM}; pg8::DupOrder<pg8::UpOrder, DUP(6)> S; S.init_up(F.G, (int)blockIdx.x);
        PG8_LAS float* rstd_l = (PG8_LAS float*)(F.lds + RSTD_OFF);
        { pg8::Unit u;
          for (int i = F.tid >> 8; i < 6 && S.pg8::UpOrder::next(i, u); i += 2) rstd_l[i * 256 + (F.tid & 255)] = pg8::rstd16((const float*)(ws + WS_SSQ1), u.arow + (F.tid & 255));
          __syncthreads(); }
        pg8::EpiUp E{(pg8::bf16_t*)(ws + WS_Z), P.fcw, P.fcb, (PG8_LAS float*)(F.lds + HALO_OFF), rstd_l};
        pg8::gemm_phase<pg8::EpiUp, pg8::DupOrder<pg8::UpOrder, DUP(6)>, true, true>(F.lds + RING_OFF, g, S, E);
    } SEAM(6);

    STAMP_BEGIN(7);
    if (IN(7)) {
        pg8::Gemm g{(const pg8::bf16_t*)(ws + WS_Z), (const pg8::bf16_t*)(ws + WS_WDN), M, DM, DFF}; pg8::DupOrder<pg8::StaticOrder, DUP(7)> S; S.init(M, DM, F.G, (int)blockIdx.x);
        pg8::EpiRes<true> E{nullptr, (const pg8::bf16_t*)(ws + WS_XB), (pg8::bf16_t*)(ws + WS_HB), (float*)(ws + WS_SSQ2)};
        pg8::gemm_phase<pg8::EpiRes<true>, pg8::DupOrder<pg8::StaticOrder, DUP(7)>, true, true>(F.lds + RING_OFF, g, S, E);
    } SEAM(7);

    STAMP_BEGIN(8);
    if (IN(8)) {
        pg8::Gemm g{(const pg8::bf16_t*)(ws + WS_HB), (const pg8::bf16_t*)(ws + WS_WG), M, DM, DM}; pg8::DupOrder<pg8::StaticOrder, DUP(8)> S; S.init(M, DM, F.G, (int)blockIdx.x);
        pg8::EpiGate E{(const pg8::bf16_t*)(ws + WS_HB), (pg8::bf16_t*)(ws + WS_XB), (const pg8::bf16_t*)(ws + WS_PP), (const float*)(ws + WS_SSQ2), (float*)(ws + WS_SSQ3)};
        pg8::gemm_phase<pg8::EpiGate, pg8::DupOrder<pg8::StaticOrder, DUP(8)>, true, true>(F.lds + RING_OFF, g, S, E);
    } SEAM(8);

    STAMP_BEGIN(9);
    if (IN(9)) { p9_final_norm(F, P); if (DUP(9)) p9_final_norm(F, P); }
    STAMP(9);
#undef IN
#undef SEAM
}

extern "C" void kernel_launch(void* const* d_in, const int* in_sizes, int n_in, void* d_out, int out_size, void* d_ws, size_t ws_size, hipStream_t stream) {
    static int grid = 0;
    if (grid == 0) {
        if (n_in != 19 || in_sizes[0] != M * DM || out_size != M * DM || ws_size < WS_END) { fprintf(stderr, "kernel_launch: unexpected shapes (n_in %d, in0 %d, out %d, ws %zu)\n", n_in, n_in > 0 ? in_sizes[0] : -1, out_size, ws_size); grid = -1; return; }
        int dev = 0, cus = 0, per_cu = 0;
        if (hipGetDevice(&dev) != hipSuccess || hipDeviceGetAttribute(&cus, hipDeviceAttributeMultiprocessorCount, dev) != hipSuccess) { grid = -1; return; }
        if (hipFuncSetAttribute((const void*)mk_fwd, hipFuncAttributeMaxDynamicSharedMemorySize, LDS_BYTES) != hipSuccess) { fprintf(stderr, "kernel_launch: hipFuncSetAttribute failed\n"); grid = -1; return; }
        if (hipOccupancyMaxActiveBlocksPerMultiprocessor(&per_cu, (const void*)mk_fwd, NWAVES * 64, LDS_BYTES) != hipSuccess || per_cu < 1) { fprintf(stderr, "kernel_launch: occupancy query says %d blocks per CU\n", per_cu); per_cu = 1; }
        (void)hipGetLastError();
        grid = cus;
    }
    if (grid < 0) return;
    if (hipMemsetAsync((char*)d_ws + WS_CTL, 0, CTL_ZERO_BYTES, stream) != hipSuccess) { fprintf(stderr, "kernel_launch: memset failed\n"); return; }
    Args a{};
    for (int i = 0; i < 19; ++i) a.in[i] = (const float*)d_in[i];
    a.out = (float*)d_out; a.ws = (unsigned char*)d_ws;
    if (N_LAUNCHES == 1) {
        a.ph_lo = 0; a.ph_hi = N_PHASES;
#if MK_COOP
        void* kargs[] = {&a};
        hipError_t e = hipLaunchCooperativeKernel((const void*)mk_fwd, dim3(grid), dim3(NWAVES * 64), kargs, LDS_BYTES, stream);
        if (e != hipSuccess) fprintf(stderr, "kernel_launch: cooperative launch failed: %s (grid %d)\n", hipGetErrorString(e), grid);
#else
        hipLaunchKernelGGL(mk_fwd, dim3(grid), dim3(NWAVES * 64), LDS_BYTES, stream, a);
        const hipError_t e = hipPeekAtLastError();
        if (e != hipSuccess) fprintf(stderr, "kernel_launch: launch failed: %s\n", hipGetErrorName(e));
#endif
    } else {
        for (int li = 0; li < N_PHASES; ++li) {
            a.ph_lo = li; a.ph_hi = li + 1;
            hipLaunchKernelGGL(mk_fwd, dim3(grid), dim3(NWAVES * 64), LDS_BYTES, stream, a);
        }
        const hipError_t le = hipPeekAtLastError();
        if (le != hipSuccess) fprintf(stderr, "kernel_launch: launch failed: %s\n", hipGetErrorName(le));
    }
}
```
